# Optimizing an MI355X kernel written in HIP

```python
import jax, jax.numpy as jnp
from jax import lax
import numpy as np

D_MODEL = 1024
BATCH = 8
SEQ = 8192
DEPTH = 2
DEC_BATCH = 32
DEC_SEQ = 16
PAST_LEN = 2048

CHUNK = 64
D_FF = 2816
EPS = 1e-6
F_MIN = 1e-30
POOL_WINDOWS = (2, 4, 8, 16)
POOL_GROUPS = 4
POOL_GROUP_DIM = 64
POOL_DIM = POOL_GROUPS * POOL_GROUP_DIM
POOL_HIST = max(POOL_WINDOWS) - 1
LRU_BLOCKS = 4
LRU_BLOCK_DIM = 64
LRU_DIM = LRU_BLOCKS * LRU_BLOCK_DIM
CONV_WIDTH = 4
LRU_C = 8.0
HG_HEADS = 4
HG_KDIM = 128
HG_VDIM = 128
HG_FDIM = HG_HEADS * HG_KDIM
HG_IDIM = HG_HEADS * HG_VDIM
MIX_DIM = POOL_DIM + LRU_DIM + HG_IDIM
IN_DIM = POOL_DIM + 2 * LRU_DIM + 2 * HG_FDIM + 2 * HG_IDIM
SPLITS = [POOL_DIM, POOL_DIM + LRU_DIM, POOL_DIM + 2 * LRU_DIM,
          POOL_DIM + 2 * LRU_DIM + HG_FDIM, POOL_DIM + 2 * LRU_DIM + 2 * HG_FDIM,
          POOL_DIM + 2 * LRU_DIM + 2 * HG_FDIM + HG_IDIM]

kernel_name = 'hybrid_pool_rglru_hgrn2_stream_step'


def rms_norm(x, g):
    xf = x.astype(jnp.float32)
    y = xf * lax.rsqrt(jnp.mean(xf * xf, axis=-1, keepdims=True) + EPS)
    return (y * g.astype(jnp.float32)).astype(x.dtype)


def swiglu(x, w_gate, w_up, w_down):
    return (jax.nn.silu(x @ w_gate) * (x @ w_up)) @ w_down


def pool_mixer(u, hist, pos0, w, scale):
    B, T, _ = u.shape
    up = jnp.concatenate([hist.astype(u.dtype), u], axis=1)
    cs = jnp.cumsum(up.astype(jnp.float32), axis=1)
    cs = jnp.concatenate([jnp.zeros((B, 1, POOL_DIM), jnp.float32), cs], axis=1)
    pos = pos0 + jnp.arange(T)
    end = cs[:, POOL_HIST + 1:]
    means = []
    for gi, win in enumerate(POOL_WINDOWS):
        sl = slice(gi * POOL_GROUP_DIM, (gi + 1) * POOL_GROUP_DIM)
        start = cs[:, POOL_HIST + 1 - win:POOL_HIST + 1 - win + T, sl]
        cnt = jnp.minimum(win, pos + 1).astype(jnp.float32)[None, :, None]
        means.append((end[..., sl] - start) / cnt)
    pooled = (jnp.concatenate(means, axis=-1) - u.astype(jnp.float32)).astype(u.dtype)
    pg = pooled.reshape(B, T, POOL_GROUPS, POOL_GROUP_DIM)
    y = jnp.einsum('btgc,gcd->btgd', pg, w).reshape(B, T, POOL_DIM) * scale
    return y, up[:, -POOL_HIST:]


def rglru_mixer(xb, gb, conv_hist, h0, pos0, conv_w, conv_b, w_a, b_a, w_x, b_x, lam):
    B, T, _ = xb.shape
    xp = jnp.concatenate([conv_hist.astype(xb.dtype), xb], axis=1)
    conv = jnp.broadcast_to(conv_b, (B, T, LRU_DIM)).astype(xb.dtype)
    for k in range(CONV_WIDTH):
        conv = conv + xp[:, k:k + T] * conv_w[k]
    xc = conv.reshape(B, T, LRU_BLOCKS, LRU_BLOCK_DIM)
    r = jax.nn.sigmoid(jnp.einsum('btgc,gcd->btgd', xc, w_a).reshape(B, T, LRU_DIM) + b_a)
    i = jax.nn.sigmoid(jnp.einsum('btgc,gcd->btgd', xc, w_x).reshape(B, T, LRU_DIM) + b_x)
    log_a = -LRU_C * jax.nn.softplus(-lam.astype(jnp.float32)) * r.astype(jnp.float32)
    a = jnp.exp(log_a)
    mult = jnp.sqrt(jnp.maximum(-jnp.expm1(2.0 * log_a), 0.0))
    pos = pos0 + jnp.arange(T)
    mult = jnp.where((pos == 0)[None, :, None], 1.0, mult)
    bterm = mult * (i * conv).astype(jnp.float32)
    bterm = bterm.at[:, 0].add(a[:, 0] * h0.astype(jnp.float32))

    def combine(left, right):
        a1, b1 = left
        a2, b2 = right
        return a1 * a2, a2 * b1 + b2

    _, h = lax.associative_scan(combine, (a, bterm), axis=1)
    y = (h * jax.nn.gelu(gb.astype(jnp.float32))).astype(xb.dtype)
    return y, xp[:, -(CONV_WIDTH - 1):], h[:, -1].astype(h0.dtype)


def hgrn2_mixer(q, fz, v, g, S0, lb, norm_g):
    B, T, _ = q.shape
    lb = lb.astype(jnp.float32)
    zf = fz.astype(jnp.float32)
    f = lb + (1.0 - lb) * jax.nn.sigmoid(zf)
    log_f = jnp.log(jnp.maximum(f, F_MIN))
    k = (1.0 - lb) * jax.nn.sigmoid(-zf)
    qf = jax.nn.silu(q.astype(jnp.float32))
    vf = v.astype(jnp.float32)
    n_chunks = -(-T // CHUNK)
    pad = n_chunks * CHUNK - T

    def to_chunks(t, dh):
        t = jnp.pad(t, ((0, 0), (0, pad), (0, 0)))
        return t.reshape(B, n_chunks, CHUNK, HG_HEADS, dh).transpose(1, 0, 3, 2, 4)

    qc, kc, fc = to_chunks(qf, HG_KDIM), to_chunks(k, HG_KDIM), to_chunks(log_f, HG_KDIM)
    vc = to_chunks(vf, HG_VDIM)
    causal = jnp.tril(jnp.ones((CHUNK, CHUNK), bool))[:, :, None]

    def step(S, inp):
        qb, kb, lfb, vb = inp
        b = jnp.cumsum(lfb, axis=-2)
        diff = b[..., :, None, :] - b[..., None, :, :]
        decay = jnp.where(causal, jnp.exp(jnp.where(causal, diff, 0.0)), 0.0)
        att = jnp.einsum('bhtk,bhsk,bhtsk->bhts', qb, kb, decay)
        o = jnp.einsum('bhts,bhsv->bhtv', att, vb) + jnp.einsum('bhtk,bhkv->bhtv', qb * jnp.exp(b), S)
        b_last = b[..., -1:, :]
        S_new = jnp.exp(b_last[..., 0, :])[..., None] * S + jnp.einsum(
            'bhsk,bhsv->bhkv', kb * jnp.exp(b_last - b), vb)
        return S_new, o

    S, o = lax.scan(step, S0.astype(jnp.float32), (qc, kc, fc, vc))
    o = o.transpose(1, 0, 3, 2, 4).reshape(B, n_chunks * CHUNK, HG_HEADS, HG_VDIM)[:, :T]
    o = o * lax.rsqrt(jnp.mean(o * o, axis=-1, keepdims=True) + EPS)
    o = o * norm_g.astype(jnp.float32).reshape(HG_HEADS, HG_VDIM)
    o = o.reshape(B, T, HG_IDIM) * jax.nn.silu(g.astype(jnp.float32))
    return o.astype(q.dtype), S.astype(S0.dtype)


def layer(x, pos0, pool_hist, conv_hist, h0, S0, lb, w):
    h = rms_norm(x, w['ffn1_norm'])
    x = x + 0.5 * swiglu(h, w['ffn1_w_gate'], w['ffn1_w_up'], w['ffn1_w_down'])
    h = rms_norm(x, w['mix_norm'])
    z = h @ w['w_in']
    u_a, xb, gb, q, fz, v, g = jnp.split(z, SPLITS, axis=-1)
    ya, new_pool = pool_mixer(u_a, pool_hist, pos0, w['pool_w'], w['pool_scale'])
    yb, new_conv, new_h = rglru_mixer(xb, gb, conv_hist, h0, pos0, w['conv_w'], w['conv_b'],
                                      w['lru_w_a'], w['lru_b_a'], w['lru_w_x'], w['lru_b_x'], w['lru_lambda'])
    yc, new_S = hgrn2_mixer(q, fz, v, g, S0, lb, w['hgrn_norm'])
    x = x + jnp.concatenate([ya, yb, yc], axis=-1) @ w['w_out']
    h = rms_norm(x, w['ffn2_norm'])
    x = x + 0.5 * swiglu(h, w['ffn2_w_gate'], w['ffn2_w_up'], w['ffn2_w_down'])
    return x, new_pool, new_conv, new_h, new_S


def setup_inputs(seed: int = 0) -> dict:
    key = jax.random.key(seed)
    ks = jax.random.split(key, 32)
    f32 = jnp.float32
    L = DEPTH

    def nrm(k, shape, scale):
        return scale * jax.random.normal(k, shape, f32)

    u = jax.random.uniform(ks[21], (L, LRU_DIM), f32, 0.9, 0.999)
    s = u ** (1.0 / LRU_C)
    lru_lambda = jnp.log(s) - jnp.log1p(-s)
    return {
        'x_prompt': nrm(ks[0], (BATCH, SEQ, D_MODEL), 1.0),
        'x_sample': nrm(ks[1], (DEC_BATCH, DEC_SEQ, D_MODEL), 1.0),
        'state_pool': nrm(ks[2], (L, DEC_BATCH, POOL_HIST, POOL_DIM), 1.0),
        'state_conv': nrm(ks[3], (L, DEC_BATCH, CONV_WIDTH - 1, LRU_DIM), 1.0),
        'state_lru': nrm(ks[4], (L, DEC_BATCH, LRU_DIM), 0.5),
        'state_hgrn': nrm(ks[5], (L, DEC_BATCH, HG_HEADS, HG_KDIM, HG_VDIM), 0.5),
        'ffn1_norm': 1.0 + nrm(ks[6], (L, D_MODEL), 0.02),
        'ffn1_w_gate': nrm(ks[7], (L, D_MODEL, D_FF), D_MODEL ** -0.5),
        'ffn1_w_up': nrm(ks[8], (L, D_MODEL, D_FF), D_MODEL ** -0.5),
        'ffn1_w_down': nrm(ks[9], (L, D_FF, D_MODEL), D_FF ** -0.5),
        'mix_norm': 1.0 + nrm(ks[10], (L, D_MODEL), 0.02),
        'w_in': nrm(ks[11], (L, D_MODEL, IN_DIM), D_MODEL ** -0.5),
        'pool_w': nrm(ks[12], (L, POOL_GROUPS, POOL_GROUP_DIM, POOL_GROUP_DIM), POOL_GROUP_DIM ** -0.5),
        'pool_scale': 1.0 + nrm(ks[13], (L, POOL_DIM), 0.02),
        'conv_w': nrm(ks[14], (L, CONV_WIDTH, LRU_DIM), CONV_WIDTH ** -0.5),
        'conv_b': nrm(ks[15], (L, LRU_DIM), 0.01),
        'lru_w_a': nrm(ks[16], (L, LRU_BLOCKS, LRU_BLOCK_DIM, LRU_BLOCK_DIM), LRU_BLOCK_DIM ** -0.5),
        'lru_b_a': nrm(ks[17], (L, LRU_DIM), 0.01),
        'lru_w_x': nrm(ks[18], (L, LRU_BLOCKS, LRU_BLOCK_DIM, LRU_BLOCK_DIM), LRU_BLOCK_DIM ** -0.5),
        'lru_b_x': nrm(ks[19], (L, LRU_DIM), 0.01),
        'lru_lambda': lru_lambda,
        'hgrn_lb_logits': nrm(ks[20], (L, HG_FDIM), 1.0),
        'hgrn_norm': 1.0 + nrm(ks[22], (L, HG_IDIM), 0.02),
        'w_out': nrm(ks[23], (L, MIX_DIM, D_MODEL), MIX_DIM ** -0.5),
        'ffn2_norm': 1.0 + nrm(ks[24], (L, D_MODEL), 0.02),
        'ffn2_w_gate': nrm(ks[25], (L, D_MODEL, D_FF), D_MODEL ** -0.5),
        'ffn2_w_up': nrm(ks[26], (L, D_MODEL, D_FF), D_MODEL ** -0.5),
        'ffn2_w_down': nrm(ks[27], (L, D_FF, D_MODEL), D_FF ** -0.5),
        'final_norm': 1.0 + nrm(ks[28], (D_MODEL,), 0.02),
    }


def reference(x_prompt, x_sample, state_pool, state_conv, state_lru, state_hgrn,
              ffn1_norm, ffn1_w_gate, ffn1_w_up, ffn1_w_down, mix_norm, w_in,
              pool_w, pool_scale, conv_w, conv_b, lru_w_a, lru_b_a, lru_w_x, lru_b_x, lru_lambda,
              hgrn_lb_logits, hgrn_norm, w_out, ffn2_norm, ffn2_w_gate, ffn2_w_up, ffn2_w_down,
              final_norm):
    lb_p = jax.nn.softmax(hgrn_lb_logits.astype(jnp.float32), axis=0)
    lower_bounds = jnp.maximum(jnp.cumsum(lb_p, axis=0) - lb_p[0], 0.0)

    def params(l):
        return {'ffn1_norm': ffn1_norm[l], 'ffn1_w_gate': ffn1_w_gate[l], 'ffn1_w_up': ffn1_w_up[l],
                'ffn1_w_down': ffn1_w_down[l], 'mix_norm': mix_norm[l], 'w_in': w_in[l],
                'pool_w': pool_w[l], 'pool_scale': pool_scale[l], 'conv_w': conv_w[l], 'conv_b': conv_b[l],
                'lru_w_a': lru_w_a[l], 'lru_b_a': lru_b_a[l], 'lru_w_x': lru_w_x[l], 'lru_b_x': lru_b_x[l],
                'lru_lambda': lru_lambda[l], 'hgrn_norm': hgrn_norm[l], 'w_out': w_out[l],
                'ffn2_norm': ffn2_norm[l], 'ffn2_w_gate': ffn2_w_gate[l], 'ffn2_w_up': ffn2_w_up[l],
                'ffn2_w_down': ffn2_w_down[l]}

    def run(x, pos0, pool, conv, lru, hg):
        pools, convs, lrus, hgs = [], [], [], []
        for l in range(DEPTH):
            x, sp, sc, sl, sh = layer(x, pos0, pool[l], conv[l], lru[l], hg[l], lower_bounds[l], params(l))
            pools.append(sp)
            convs.append(sc)
            lrus.append(sl)
            hgs.append(sh)
        return (rms_norm(x, final_norm), jnp.stack(pools), jnp.stack(convs),
                jnp.stack(lrus), jnp.stack(hgs))

    bp = x_prompt.shape[0]
    dt = x_prompt.dtype
    zero_pool = jnp.zeros((DEPTH, bp, POOL_HIST, POOL_DIM), dt)
    zero_conv = jnp.zeros((DEPTH, bp, CONV_WIDTH - 1, LRU_DIM), dt)
    zero_lru = jnp.zeros((DEPTH, bp, LRU_DIM), dt)
    zero_hgrn = jnp.zeros((DEPTH, bp, HG_HEADS, HG_KDIM, HG_VDIM), dt)
    y_prompt, pool_p, conv_p, lru_p, hgrn_p = run(x_prompt, 0, zero_pool, zero_conv, zero_lru, zero_hgrn)
    y_sample, pool_s, conv_s, lru_s, hgrn_s = run(x_sample, PAST_LEN, state_pool, state_conv, state_lru, state_hgrn)
    return (y_prompt, y_sample, pool_p, conv_p, lru_p, hgrn_p, pool_s, conv_s, lru_s, hgrn_s)
```

```cpp
#include <hip/hip_runtime.h>
#include <hip/hip_cooperative_groups.h>
#include <cstdio>
#include <cstdint>
namespace cg = cooperative_groups;
namespace pg8 {
#define PG8_LAS __attribute__((address_space(3)))
typedef unsigned short bf16_t;
typedef short bf16x8 __attribute__((ext_vector_type(8)));
typedef float f32x4 __attribute__((ext_vector_type(4)));
typedef unsigned u32x4 __attribute__((ext_vector_type(4)));
constexpr int BM = 256, BK = 64, HALF = 128, HTB = HALF * BK * 2  , STAGE_BYTES = 8 * HTB, NXCD = 8, WGM = 8;

__host__ __device__ __forceinline__ int lds_byte(int r, int c) { const int st = (r >> 4) * 2 + (c >> 5), rr = r & 15, cc = c & 31, ob = rr * 64 + cc * 2; return st * 1024 + (ob ^ (((ob >> 9) & 1) << 5)); }
__host__ __device__ __forceinline__ void stage_rc(int b, int& R, int& C) { const int st = b / 1024, sb = b % 1024, swz = sb ^ (((sb >> 9) & 1) << 5); R = (st >> 1) * 16 + swz / 64; C = (st & 1) * 32 + (swz % 64) / 2; }
__host__ __device__ __forceinline__ int perm32(int rho) { const int n = rho >> 4, i = rho & 15; return 8 * (i >> 2) + 4 * n + (i & 3); }

constexpr int PART_NT = 4;
struct Unit { int pm, pn, kc; };
struct Gemm { const bf16_t* A; const bf16_t* Bt; int M, N, K; };

struct StaticOrder {
    int nM, nN, nwg, G, c;
    __host__ __device__ void init(int M, int N, int G_, int c_) { nM = M / BM; nN = N / BM; nwg = nM * nN; G = G_; c = c_; }
    __host__ __device__ void map(int L, int& pm, int& pn) const {
        int wgid = L; { const int q = nwg / NXCD, r = nwg % NXCD, xcd = wgid % NXCD, off = wgid / NXCD; wgid = (xcd < r ? xcd * (q + 1) : r * (q + 1) + (xcd - r) * q) + off; }
        const int nig = WGM * nN, gid = wgid / nig, fm = gid * WGM, gsz = (nM - fm) < WGM ? (nM - fm) : WGM;
        pm = fm + ((wgid % nig) % gsz); pn = (wgid % nig) / gsz;
    }
    __host__ __device__ bool next(int i, Unit& u) const {
        const long L = (long)i * G + c; if (L >= nwg) return false;
        int pm, pn; map((int)L, pm, pn); u.pm = pm; u.pn = pn; u.kc = -1; return true;
    }
    __device__ __forceinline__ void a_ready(const Unit&) const {}
    __device__ __forceinline__ void done(const Unit&) const {}
};

__device__ __forceinline__ unsigned cvt_pk_bf16(float lo, float hi) { unsigned r; asm volatile("v_cvt_pk_bf16_f32 %0, %1, %2" : "=v"(r) : "v"(lo), "v"(hi)); return r; }
template <class Epi, class Sched, bool ALIGN_EPI = false, bool SP2 = false>
__device__ __forceinline__ void gemm_phase(PG8_LAS unsigned char* lds, const Gemm g, const Sched& S, const Epi& E) {
    int tid_ = threadIdx.x; asm volatile("" : "+v"(tid_));
    const int tid = tid_, wid = __builtin_amdgcn_readfirstlane(tid >> 6), lane = tid & 63, wr = wid >> 2, wc = wid & 3, fr = lane & 15, fq = lane >> 4;
    const int K = g.K, nt = K / BK;
    unsigned voffA[2], voffB[2];
#pragma unroll
    for (int i = 0; i < 2; ++i) { int R, C; stage_rc(tid * 16 + i * 8192, R, C); const int Rb = Epi::PERM ? ((R & ~31) + perm32(R & 31)) : R;
        voffA[i] = (unsigned)(R * K + C) * 2u; voffB[i] = (unsigned)(Rb * K + C) * 2u; }
    const size_t kstep = (size_t)(BK * 2);
    const size_t hstep = (size_t)HALF * K * 2;
    const size_t tstep = 2 * hstep;
    const unsigned ldsw = (unsigned)wid * 1024u;
    const int aoff = lds_byte(wr * 64 + fr, fq * 8), boff = lds_byte(wc * 32 + fr, fq * 8);
#define PG8_SA(b, h) (((b) * 2 + (h)) * HTB)
#define PG8_SB(b, h) ((4 + (b) * 2 + (h)) * HTB)
#define PG8_STAGE(bufoff, gbase, voff) do { _Pragma("unroll") for (int _i = 0; _i < 2; ++_i) \
        __builtin_amdgcn_global_load_lds((const unsigned*)((const char*)(gbase) + (voff)[_i]), (PG8_LAS unsigned*)(lds + (bufoff) + ldsw + _i * 8192), 16, 0, 0); } while (0)
#define PG8_LDA(dst, b, h) do { _Pragma("unroll") for (int m = 0; m < 4; ++m) _Pragma("unroll") for (int k = 0; k < 2; ++k) dst[m][k] = *(const PG8_LAS bf16x8*)(lds + PG8_SA(b, h) + aoff + m * 2048 + k * 1024); } while (0)
#define PG8_LDB(dst, b, h) do { _Pragma("unroll") for (int n = 0; n < 2; ++n) _Pragma("unroll") for (int k = 0; k < 2; ++k) dst[n][k] = *(const PG8_LAS bf16x8*)(lds + PG8_SB(b, h) + boff + n * 2048 + k * 1024); } while (0)
#define PG8_MMA(ai, bj, At, Bt) do { __builtin_amdgcn_s_setprio(1); _Pragma("unroll") for (int m = 0; m < 4; ++m) _Pragma("unroll") for (int n = 0; n < 2; ++n) _Pragma("unroll") for (int k = 0; k < 2; ++k) \
        acc[ai][bj][m][n] = __builtin_amdgcn_mfma_f32_16x16x32_bf16(Bt[n][k], At[m][k], acc[ai][bj][m][n], 0, 0, 0); __builtin_amdgcn_s_setprio(0); } while (0)
#define PG8_WAIT_V(n) asm volatile("s_waitcnt vmcnt(" #n ")" ::: "memory")
#define PG8_WAIT_L(n) asm volatile("s_waitcnt lgkmcnt(" #n ")" ::: "memory")
#define PG8_BAR __builtin_amdgcn_s_barrier()
#define PG8_SCHED __builtin_amdgcn_sched_barrier(0)
    Unit cur, nxt; int ui = 0;
    if (!S.next(0, cur)) return;
    f32x4 acc[2][2][4][2];
#pragma unroll
    for (int a = 0; a < 2; ++a)
#pragma unroll
        for (int b = 0; b < 2; ++b)
#pragma unroll
            for (int m = 0; m < 4; ++m)
#pragma unroll
                for (int n = 0; n < 2; ++n) acc[a][b][m][n] = (f32x4){0.f, 0.f, 0.f, 0.f};
    bf16x8 At[4][2], B0[2][2], B1[2][2];
    const char* cA = (const char*)g.A + (size_t)cur.pm * tstep + (cur.kc >= 0 ? cur.kc * (PART_NT * BK * 2) : 0); const char* cB = (const char*)g.Bt + (size_t)cur.pn * tstep + (cur.kc >= 0 ? cur.kc * (PART_NT * BK * 2) : 0);
    S.a_ready(cur);
    if (wr == 1) E.stage(cur, lds, wid, lane);
    if constexpr (SP2) {
        PG8_STAGE(PG8_SB(0, 0), cB, voffB); PG8_STAGE(PG8_SB(0, 1), cB + hstep, voffB); PG8_STAGE(PG8_SA(0, 0), cA, voffA); PG8_STAGE(PG8_SA(0, 1), cA + hstep, voffA);
        if (wr == 1) PG8_BAR;
        PG8_WAIT_V(2); PG8_BAR;
        PG8_STAGE(PG8_SB(1, 0), cB + kstep, voffB); PG8_STAGE(PG8_SA(1, 0), cA + kstep, voffA); PG8_STAGE(PG8_SB(1, 1), cB + hstep + kstep, voffB);
        PG8_WAIT_V(6); PG8_BAR;
    } else {
        PG8_STAGE(PG8_SB(0, 0), cB, voffB); PG8_STAGE(PG8_SA(0, 0), cA, voffA); PG8_STAGE(PG8_SB(0, 1), cB + hstep, voffB); PG8_STAGE(PG8_SA(0, 1), cA + hstep, voffA);
        if (wr == 1) PG8_BAR;
        PG8_WAIT_V(4); PG8_BAR;
        PG8_STAGE(PG8_SB(1, 0), cB + kstep, voffB); PG8_STAGE(PG8_SA(1, 0), cA + kstep, voffA); PG8_STAGE(PG8_SB(1, 1), cB + hstep + kstep, voffB);
        PG8_WAIT_V(6); PG8_BAR;
    }
    for (;;) {
        const bool has_next = S.next(ui + 1, nxt);
        const char* nA = has_next ? (const char*)g.A + (size_t)nxt.pm * tstep + (nxt.kc >= 0 ? nxt.kc * (PART_NT * BK * 2) : 0) : cA; const char* nB = has_next ? (const char*)g.Bt + (size_t)nxt.pn * tstep + (nxt.kc >= 0 ? nxt.kc * (PART_NT * BK * 2) : 0) : cB;
        const int unt = __builtin_amdgcn_readfirstlane(cur.kc >= 0 ? PART_NT : nt);
        for (int t = 0; t < unt; t += 2) {
            const bool last = (t == unt - 2);
            const char* a1 = cA + (size_t)(t + 1) * kstep;
            const char* a2 = last ? nA : cA + (size_t)(t + 2) * kstep; const char* b2 = last ? nB : cB + (size_t)(t + 2) * kstep;
            const char* a3 = a2 + kstep; const char* b3 = b2 + kstep;
            if (last && has_next) S.a_ready(nxt);
            if constexpr (SP2) {
            PG8_LDB(B0, 0, 0); PG8_LDB(B1, 0, 1); PG8_SCHED; PG8_LDA(At, 0, 0); PG8_STAGE(PG8_SA(1, 1), a1 + hstep, voffA);
            PG8_WAIT_V(8); PG8_WAIT_L(0); PG8_BAR; PG8_MMA(0, 0, At, B0); PG8_MMA(0, 1, At, B1); PG8_BAR; PG8_SCHED;
            PG8_LDA(At, 0, 1); PG8_STAGE(PG8_SB(0, 0), b2, voffB); PG8_STAGE(PG8_SB(0, 1), b2 + hstep, voffB); PG8_STAGE(PG8_SA(0, 0), a2, voffA);
            PG8_WAIT_V(8); PG8_WAIT_L(0); PG8_BAR; PG8_MMA(1, 0, At, B0); PG8_MMA(1, 1, At, B1); PG8_BAR; PG8_SCHED;
            PG8_LDB(B0, 1, 0); PG8_LDB(B1, 1, 1); PG8_SCHED; PG8_LDA(At, 1, 0); PG8_STAGE(PG8_SA(0, 1), a2 + hstep, voffA);
            PG8_WAIT_V(8); PG8_WAIT_L(0); PG8_BAR; PG8_MMA(0, 0, At, B0); PG8_MMA(0, 1, At, B1); PG8_BAR; PG8_SCHED;
            PG8_LDA(At, 1, 1); PG8_STAGE(PG8_SB(1, 0), b3, voffB); PG8_STAGE(PG8_SB(1, 1), b3 + hstep, voffB); PG8_STAGE(PG8_SA(1, 0), a3, voffA);
            PG8_WAIT_V(8); PG8_WAIT_L(0); PG8_BAR; PG8_MMA(1, 0, At, B0); PG8_MMA(1, 1, At, B1); PG8_BAR; PG8_SCHED;
            } else {
            PG8_LDB(B0, 0, 0); PG8_SCHED; PG8_LDA(At, 0, 0); PG8_STAGE(PG8_SA(1, 1), a1 + hstep, voffA);
            PG8_WAIT_L(8); PG8_BAR; PG8_WAIT_L(0); PG8_MMA(0, 0, At, B0); PG8_BAR; PG8_SCHED;
            PG8_LDB(B1, 0, 1); PG8_STAGE(PG8_SB(0, 0), b2, voffB);
            PG8_BAR; PG8_WAIT_L(0); PG8_MMA(0, 1, At, B1); PG8_BAR;
            PG8_LDA(At, 0, 1); PG8_STAGE(PG8_SA(0, 0), a2, voffA);
            PG8_BAR; PG8_WAIT_L(0); PG8_MMA(1, 0, At, B0); PG8_BAR; PG8_SCHED;
            PG8_STAGE(PG8_SB(0, 1), b2 + hstep, voffB);
            PG8_WAIT_V(6); PG8_BAR; PG8_MMA(1, 1, At, B1); PG8_BAR;
            PG8_LDB(B0, 1, 0); PG8_SCHED; PG8_LDA(At, 1, 0); PG8_STAGE(PG8_SA(0, 1), a2 + hstep, voffA);
            PG8_WAIT_L(8); PG8_BAR; PG8_WAIT_L(0); PG8_MMA(0, 0, At, B0); PG8_BAR; PG8_SCHED;
            PG8_LDB(B1, 1, 1); PG8_STAGE(PG8_SB(1, 0), b3, voffB);
            PG8_BAR; PG8_WAIT_L(0); PG8_MMA(0, 1, At, B1); PG8_BAR;
            PG8_LDA(At, 1, 1); PG8_STAGE(PG8_SA(1, 0), a3, voffA);
            PG8_BAR; PG8_WAIT_L(0); PG8_MMA(1, 0, At, B0); PG8_BAR; PG8_SCHED;
            PG8_STAGE(PG8_SB(1, 1), b3 + hstep, voffB);
            PG8_WAIT_V(6); PG8_BAR; PG8_MMA(1, 1, At, B1); PG8_BAR;
            }
        }
        if constexpr (ALIGN_EPI) { if (wr == 0) PG8_BAR; }
        if constexpr (!Epi::AFTER_DRAIN) { E(acc, cur, wr, wc, fr, fq); S.done(cur); }
        if (!has_next) break;
#pragma unroll
        for (int a = 0; a < 2; ++a)
#pragma unroll
            for (int b = 0; b < 2; ++b)
#pragma unroll
                for (int m = 0; m < 4; ++m)
#pragma unroll
                    for (int n = 0; n < 2; ++n) acc[a][b][m][n] = (f32x4){0.f, 0.f, 0.f, 0.f};
        cur = nxt; cA = nA; cB = nB; ++ui;
        if constexpr (ALIGN_EPI) { if (wr == 1) { PG8_BAR; E.stage(cur, lds, wid, lane); } }
    }
    PG8_WAIT_V(0);
    if constexpr (!ALIGN_EPI) { if (wr == 0) PG8_BAR; }
    PG8_BAR;
    if constexpr (Epi::AFTER_DRAIN) { E.fused(acc, cur, wr, wc, fr, fq, lds, wid, lane); S.done(cur); }
#undef PG8_SA
#undef PG8_SB
#undef PG8_STAGE
#undef PG8_LDA
#undef PG8_LDB
#undef PG8_MMA
#undef PG8_WAIT_V
#undef PG8_WAIT_L
#undef PG8_BAR
#undef PG8_SCHED
}
}

#define LAS __attribute__((address_space(3)))
#define DI __device__ __forceinline__
typedef unsigned short bf16;
typedef float f32x4 __attribute__((ext_vector_type(4)));
typedef float f32x2 __attribute__((ext_vector_type(2)));
typedef short bf16x8 __attribute__((ext_vector_type(8)));
typedef unsigned u32x4 __attribute__((ext_vector_type(4)));
typedef unsigned u32x2 __attribute__((ext_vector_type(2)));

constexpr int NT = 512;
constexpr int D = 1024, DFF = 2816, INW = 2816;
constexpr int MP = 65536, MS = 512, M = MP + MS;
constexpr int NCH_P = 1024, NCH_S = 32, NCH = NCH_P + NCH_S;
constexpr float EPS = 1e-6f;
constexpr int ZC_POOL = 0, ZC_XB = 256, ZC_GB = 512, ZC_Q = 768, ZC_F = 1280, ZC_V = 1792, ZC_G = 2304;
constexpr size_t O_YP = 0, O_YS = (size_t)MP * D, O_POOLP = O_YS + (size_t)MS * D, O_CONVP = O_POOLP + 2 * 8 * 15 * 256, O_LRUP = O_CONVP + 2 * 8 * 3 * 256,
                 O_HGP = O_LRUP + 2 * 8 * 256, O_POOLS = O_HGP + (size_t)2 * 8 * 4 * 16384, O_CONVS = O_POOLS + 2 * 32 * 15 * 256, O_LRUS = O_CONVS + 2 * 32 * 3 * 256,
                 O_HGS = O_LRUS + 2 * 32 * 256, O_END = O_HGS + (size_t)2 * 32 * 4 * 16384;
constexpr size_t MiB = 1u << 20;
constexpr size_t SZ_WGU = (size_t)5632 * 1024 * 2, SZ_WD = (size_t)1024 * 2816 * 2, SZ_WIN = (size_t)2816 * 1024 * 2, SZ_WOUT = (size_t)1024 * 1024 * 2;
constexpr size_t WS_BAR = 262144;
constexpr size_t WS_WG = 65536;
constexpr size_t WS_WGU = 1 * MiB, WS_WD = 45 * MiB, WS_WIN = 67 * MiB, WS_WOUT = 78 * MiB, WS_SSQ = 82 * MiB, WS_LB = 0, WS_DEC = 87 * MiB, WS_CARRY = 90 * MiB,
                 WS_XB = 92 * MiB, WS_HZ = 221 * MiB, WS_MIX = 576 * MiB, WS_US = 705 * MiB, WS_HL = 837 * MiB, WS_PP = 902 * MiB, WS_END = 967 * MiB;
static_assert(WS_WGU + 4 * SZ_WGU <= WS_WD && WS_WD + 4 * SZ_WD <= WS_WIN && WS_WIN + 2 * SZ_WIN <= WS_WOUT && WS_WOUT + 2 * SZ_WOUT <= WS_SSQ, "ws map 1");
static_assert(WS_SSQ + (size_t)M * 16 * 4 <= WS_DEC && WS_DEC + (size_t)NCH * 512 * 4 <= WS_CARRY && WS_CARRY + (size_t)NCH * 256 * 4 <= WS_XB, "ws map 2");
static_assert(WS_XB + (size_t)M * D * 2 <= WS_HZ && WS_HZ + (size_t)M * INW * 2 <= WS_MIX && WS_MIX + (size_t)M * D * 2 <= WS_US && WS_US + (size_t)NCH * 4 * 16384 * 2 <= WS_HL, "ws map 3");
static_assert(WS_HL + (size_t)M * 256 * 4 <= WS_PP && WS_PP + (size_t)M * 256 * 4 <= WS_END, "ws map 4");
constexpr int LDS_BYTES = 147456 + 2048;

struct Args { const float* in[29]; float* out; unsigned char* ws; int ph_lo, ph_hi; };

DI float bf2f(bf16 v) { return __uint_as_float((unsigned)v << 16); }
typedef __bf16 hwbf16x2 __attribute__((ext_vector_type(2)));
DI unsigned pk2(float lo, float hi) { const f32x2 v = {lo, hi}; const hwbf16x2 b = __builtin_convertvector(v, hwbf16x2); return __builtin_bit_cast(unsigned, b); }
DI unsigned f2bf(float f) { return pk2(f, 0.f) & 0xffffu; }
DI float frcp(float x) { return __builtin_amdgcn_rcpf(x); }
DI float fexp(float x) { return __builtin_amdgcn_exp2f(x * 1.4426950408889634f); }
DI float sigm(float x) { return frcp(1.f + fexp(-x)); }
DI float siluf(float x) { return x * frcp(1.f + fexp(-x)); }
DI float gelu_tanh(float x) { const float u = 0.7978845608028654f * (x + 0.044715f * x * x * x); return x * frcp(1.f + fexp(-2.f * u)); }
DI float clampf(float x, float lo, float hi) { return fminf(fmaxf(x, lo), hi); }
DI float wave_sum(float v) {
#pragma unroll
    for (int o = 1; o < 64; o <<= 1) v += __shfl_xor(v, o);
    return v;
}
DI int opaque_i(int v) { v = __builtin_amdgcn_readfirstlane(v); asm volatile("" : "+s"(v)); return v; }
DI int opaque_bid() { int b = blockIdx.x; asm volatile("" : "+s"(b)); return b; }
#define LDS_WAIT() asm volatile("s_waitcnt lgkmcnt(0)" ::: "memory")
#define BAR_LDS() do { asm volatile("s_waitcnt lgkmcnt(0)" ::: "memory"); __builtin_amdgcn_s_barrier(); asm volatile("" ::: "memory"); } while (0)
DI f32x4 mfma16(bf16x8 a, bf16x8 b, f32x4 c) { return __builtin_amdgcn_mfma_f32_16x16x32_bf16(a, b, c, 0, 0, 0); }

struct Chunk { int row0, nv, b, cis, smp; };
DI Chunk get_chunk(int ci) { Chunk c; if (ci < NCH_P) { c.b = ci >> 7; c.cis = ci & 127; c.row0 = ci * 64; c.nv = 64; c.smp = 0; } else { c.b = ci - NCH_P; c.cis = 0; c.row0 = MP + 16 * c.b; c.nv = 16; c.smp = 1; } return c; }

DI float row_rstd(const float* ssq, int row) {
    const f32x4* p = (const f32x4*)(ssq + (size_t)row * 16);
    const f32x4 a = p[0], b = p[1], c = p[2], d = p[3];
    const float s = ((a.x + a.y) + (a.z + a.w)) + ((b.x + b.y) + (b.z + b.w)) + ((c.x + c.y) + (c.z + c.w)) + ((d.x + d.y) + (d.z + d.w));
    return rsqrtf(s * (1.f / 1024.f) + EPS);
}
DI void rows_rstd(const float* ssq, int row0, int fq, float (&r)[2][4]) {
    f32x4 p[2][4];
#pragma unroll
    for (int ai = 0; ai < 2; ++ai)
#pragma unroll
        for (int m = 0; m < 4; ++m) p[ai][m] = *(const f32x4*)(ssq + (size_t)(row0 + ai * 128 + m * 16) * 16 + fq * 4);
#pragma unroll
    for (int ai = 0; ai < 2; ++ai)
#pragma unroll
        for (int m = 0; m < 4; ++m) { float s = (p[ai][m][0] + p[ai][m][1]) + (p[ai][m][2] + p[ai][m][3]); s += __shfl_xor(s, 16); s += __shfl_xor(s, 32); r[ai][m] = rsqrtf(s * (1.f / 1024.f) + EPS); }
}
constexpr int L_SSQT = 131072;
DI void stage_ssq_tile(const float* ssq, int pm, LAS unsigned char* lds, int wid, int lane) {
#pragma unroll
    for (int j = 0; j < 4; ++j)
        __builtin_amdgcn_global_load_lds((const unsigned*)(ssq + (size_t)pm * 4096 + ((wid - 4) * 4 + j) * 256 + lane * 4), (LAS unsigned*)(lds + L_SSQT + ((wid - 4) * 4 + j) * 1024), 16, 0, 0);
}
constexpr int L_RSTD = L_SSQT + 16384;
DI void rows_rstd_coop(LAS unsigned char* lds, int wr, int wc, int fr, int fq, float (&r)[2][4]) {
    const int tid = (wr * 4 + wc) * 64 + fq * 16 + fr, row = tid >> 1, hh = tid & 1;
    const f32x4 p0 = *(const LAS f32x4*)(lds + L_SSQT + row * 64 + hh * 32), p1 = *(const LAS f32x4*)(lds + L_SSQT + row * 64 + hh * 32 + 16);
    float s = ((p0[0] + p0[1]) + (p0[2] + p0[3])) + ((p1[0] + p1[1]) + (p1[2] + p1[3]));
    s += __shfl_xor(s, 1);
    if (hh == 0) *(LAS float*)(lds + L_RSTD + row * 4) = __builtin_amdgcn_rsqf(s * (1.f / 1024.f) + EPS);
    asm volatile("s_waitcnt lgkmcnt(0)" ::: "memory"); __builtin_amdgcn_s_barrier(); asm volatile("" ::: "memory");
#pragma unroll
    for (int ai = 0; ai < 2; ++ai)
#pragma unroll
        for (int m = 0; m < 4; ++m) r[ai][m] = *(const LAS float*)(lds + L_RSTD + (wr * 64 + fr + ai * 128 + m * 16) * 4);
}
struct EpiSwiglu {
    static constexpr bool PERM = true, AFTER_DRAIN = false;
    bf16* H; const float* ssq; LAS unsigned char* lds;
    DI void stage(const pg8::Unit& u, LAS unsigned char* l, int wid, int lane) const { stage_ssq_tile(ssq, u.pm, l, wid, lane); }
    DI void operator()(const f32x4 (&acc)[2][2][4][2], const pg8::Unit& u, int wr, int wc, int fr, int fq) const {
        const int row0 = u.pm * 256 + wr * 64 + fr, col = u.pn * 128 + wc * 32 + 8 * fq;
        float rr[2][4]; rows_rstd_coop(lds, wr, wc, fr, fq, rr);
#pragma unroll
        for (int ai = 0; ai < 2; ++ai)
#pragma unroll
            for (int m = 0; m < 4; ++m) {
                const int row = row0 + ai * 128 + m * 16; const float r = rr[ai][m];
                float h[8];
                const float rl = -1.4426950408889634f * r, r2 = r * r;
#pragma unroll
                for (int n = 0; n < 2; ++n)
#pragma unroll
                    for (int j = 0; j < 4; ++j) { const float g = acc[ai][0][m][n][j], up = acc[ai][1][m][n][j]; h[n * 4 + j] = (g * up) * r2 * frcp(1.f + __builtin_amdgcn_exp2f(g * rl)); }
                u32x4 w; w.x = pk2(h[0], h[1]); w.y = pk2(h[2], h[3]); w.z = pk2(h[4], h[5]); w.w = pk2(h[6], h[7]);
                *(u32x4*)(H + (size_t)row * DFF + col) = w;
            }
    }
};
struct EpiScale {
    static constexpr bool PERM = true, AFTER_DRAIN = false;
    bf16* Z; const float* ssq; int ldc; LAS unsigned char* lds;
    DI void stage(const pg8::Unit& u, LAS unsigned char* l, int wid, int lane) const { stage_ssq_tile(ssq, u.pm, l, wid, lane); }
    DI void operator()(const f32x4 (&acc)[2][2][4][2], const pg8::Unit& u, int wr, int wc, int fr, int fq) const {
        const int row0 = u.pm * 256 + wr * 64 + fr, col0 = u.pn * 256 + wc * 32 + 8 * fq;
        float rr[2][4]; rows_rstd_coop(lds, wr, wc, fr, fq, rr);
#pragma unroll
        for (int ai = 0; ai < 2; ++ai)
#pragma unroll
            for (int m = 0; m < 4; ++m) {
                const int row = row0 + ai * 128 + m * 16; const float r = rr[ai][m];
#pragma unroll
                for (int bj = 0; bj < 2; ++bj) {
                    const f32x4 v0 = acc[ai][bj][m][0] * r, v1 = acc[ai][bj][m][1] * r;
                    u32x4 w; w.x = pk2(v0[0], v0[1]); w.y = pk2(v0[2], v0[3]); w.z = pk2(v1[0], v1[1]); w.w = pk2(v1[2], v1[3]);
                    *(u32x4*)(Z + (size_t)row * ldc + col0 + bj * 128) = w;
                }
            }
    }
};
constexpr int KSPLIT = 11, KSPLIT_NT = pg8::PART_NT;
struct EpiResid {
    static constexpr bool PERM = true, AFTER_DRAIN = false;
    const bf16* XBin; bf16* XB; float* ssq; float alpha; float* part;
    DI void stage(const pg8::Unit&, LAS unsigned char*, int, int) const {}
    DI void operator()(const f32x4 (&acc)[2][2][4][2], const pg8::Unit& u, int wr, int wc, int fr, int fq) const {
        if (u.kc >= 0) {
            float* pt = part + ((size_t)(((u.pm - MP / 256) * 4 + u.pn) * KSPLIT + u.kc)) * 65536 + (size_t)(wr * 64 + fr) * 256 + wc * 32 + 8 * fq;
#pragma unroll
            for (int ai = 0; ai < 2; ++ai)
#pragma unroll
                for (int m = 0; m < 4; ++m)
#pragma unroll
                    for (int bj = 0; bj < 2; ++bj) { float* q = pt + (size_t)(ai * 128 + m * 16) * 256 + bj * 128; *(f32x4*)q = acc[ai][bj][m][0]; *(f32x4*)(q + 4) = acc[ai][bj][m][1]; }
            return;
        }
        const int row0 = u.pm * 256 + wr * 64 + fr, col0 = u.pn * 256 + wc * 32 + 8 * fq;
#pragma unroll
        for (int ai = 0; ai < 2; ++ai) {
            u32x4 bb[4][2];
#pragma unroll
            for (int m = 0; m < 4; ++m)
#pragma unroll
                for (int bj = 0; bj < 2; ++bj) bb[m][bj] = *(const u32x4*)(XBin + (size_t)(row0 + ai * 128 + m * 16) * D + col0 + bj * 128);
#pragma unroll
            for (int m = 0; m < 4; ++m) {
                const int row = row0 + ai * 128 + m * 16;
                float sq = 0.f;
#pragma unroll
                for (int bj = 0; bj < 2; ++bj) {
                    const int col = col0 + bj * 128;
                    const u32x4 b = bb[m][bj];
                    f32x4 v0, v1;
                    v0[0] = __uint_as_float(b.x << 16) + alpha * acc[ai][bj][m][0][0]; v0[1] = __uint_as_float(b.x & 0xffff0000u) + alpha * acc[ai][bj][m][0][1];
                    v0[2] = __uint_as_float(b.y << 16) + alpha * acc[ai][bj][m][0][2]; v0[3] = __uint_as_float(b.y & 0xffff0000u) + alpha * acc[ai][bj][m][0][3];
                    v1[0] = __uint_as_float(b.z << 16) + alpha * acc[ai][bj][m][1][0]; v1[1] = __uint_as_float(b.z & 0xffff0000u) + alpha * acc[ai][bj][m][1][1];
                    v1[2] = __uint_as_float(b.w << 16) + alpha * acc[ai][bj][m][1][2]; v1[3] = __uint_as_float(b.w & 0xffff0000u) + alpha * acc[ai][bj][m][1][3];
                    u32x4 w; w.x = pk2(v0[0], v0[1]); w.y = pk2(v0[2], v0[3]); w.z = pk2(v1[0], v1[1]); w.w = pk2(v1[2], v1[3]);
                    *(u32x4*)(XB + (size_t)row * D + col) = w;
                    const float r0 = __uint_as_float(w.x << 16), r1 = __uint_as_float(w.x & 0xffff0000u), r2 = __uint_as_float(w.y << 16), r3 = __uint_as_float(w.y & 0xffff0000u),
                                r4 = __uint_as_float(w.z << 16), r5 = __uint_as_float(w.z & 0xffff0000u), r6 = __uint_as_float(w.w << 16), r7 = __uint_as_float(w.w & 0xffff0000u);
                    sq += (r0 * r0 + r1 * r1) + (r2 * r2 + r3 * r3) + (r4 * r4 + r5 * r5) + (r6 * r6 + r7 * r7);
                }
                sq += __shfl_xor(sq, 16); sq += __shfl_xor(sq, 32);
                if (fq == 0) ssq[(size_t)row * 16 + u.pn * 4 + wc] = sq;
            }
        }
    }
};

struct DownOrder {
    pg8::StaticOrder so;
    DI void init(int G, int c) { so.init(MP, D, G, c); }
    DI bool next(int i, pg8::Unit& u) const {
        const long L = (long)i * so.G + so.c;
        if (L >= so.nwg + 8 * KSPLIT) return false;
        const bool prompt = L < so.nwg;
        int pm, pn; so.map(prompt ? (int)L : 0, pm, pn);
        const int s = prompt ? 0 : (int)(L - so.nwg), t8 = s / KSPLIT;
        u.pm = prompt ? pm : MP / 256 + (t8 >> 2); u.pn = prompt ? pn : (t8 & 3); u.kc = prompt ? -1 : s - t8 * KSPLIT;
        return true;
    }
    DI void a_ready(const pg8::Unit&) const {}
    DI void done(const pg8::Unit&) const {}
};
DI void down_reduce(const Args& a) {
    int tid_ = threadIdx.x; asm volatile("" : "+v"(tid_));
    const int lane = tid_ & 63, gw = opaque_bid() * 8 + (tid_ >> 6), NGW = opaque_i(gridDim.x * 8);
    const float* part = (const float*)(a.ws + WS_US); bf16* XB = (bf16*)(a.ws + WS_XB); float* SSQ = (float*)(a.ws + WS_SSQ);
    for (int it = gw; it < MS * 4; it += NGW) {
        const int r = it >> 2, pn = it & 3;
        const float* pt = part + ((size_t)(((r >> 8) * 4 + pn) * KSPLIT)) * 65536 + (size_t)(r & 255) * 256 + lane * 4;
        f32x4 sm = (f32x4){0.f, 0.f, 0.f, 0.f};
#pragma unroll
        for (int kc = 0; kc < KSPLIT; ++kc) sm += *(const f32x4*)(pt + (size_t)kc * 65536);
        u32x2* xp = (u32x2*)(XB + (size_t)(MP + r) * D + pn * 256 + lane * 4); const u32x2 b = *xp;
        u32x2 o; o.x = pk2(__uint_as_float(b.x << 16) + 0.5f * sm[0], __uint_as_float(b.x & 0xffff0000u) + 0.5f * sm[1]); o.y = pk2(__uint_as_float(b.y << 16) + 0.5f * sm[2], __uint_as_float(b.y & 0xffff0000u) + 0.5f * sm[3]);
        *xp = o;
        const float r0 = __uint_as_float(o.x << 16), r1 = __uint_as_float(o.x & 0xffff0000u), r2 = __uint_as_float(o.y << 16), r3 = __uint_as_float(o.y & 0xffff0000u);
        const float sq = wave_sum((r0 * r0 + r1 * r1) + (r2 * r2 + r3 * r3));
        if (lane < 4) SSQ[(size_t)(MP + r) * 16 + pn * 4 + lane] = (lane == 0) ? sq : 0.f;
    }
}

DI void transpose_item(const float* W, int N, int Kdst, const float* gain, bf16* WT, int dst_row0, int kdst0, LAS float* scr, int k0, int n0, int lane) {
    {
        const int kr = lane >> 3, nc = (lane & 7) * 4; f32x4 w[8]; float g[8];
#pragma unroll
        for (int i = 0; i < 8; ++i) { const int kk = kr + 8 * i; w[i] = *(const f32x4*)(W + (size_t)(k0 + kk) * N + n0 + nc); g[i] = gain ? gain[k0 + kk] : 1.f; }
#pragma unroll
        for (int i = 0; i < 8; ++i) { const int kk = kr + 8 * i; LAS float* d = scr + kk * 33 + nc; d[0] = w[i][0] * g[i]; d[1] = w[i][1] * g[i]; d[2] = w[i][2] * g[i]; d[3] = w[i][3] * g[i]; }
    }
    LDS_WAIT(); asm volatile("" ::: "memory");
    const int c = lane & 7;
#pragma unroll
    for (int j = 0; j < 4; ++j) { const int n = (lane >> 3) + 8 * j; const LAS float* s = scr + (8 * c) * 33 + n;
        u32x4 o; o.x = pk2(s[0 * 33], s[1 * 33]); o.y = pk2(s[2 * 33], s[3 * 33]); o.z = pk2(s[4 * 33], s[5 * 33]); o.w = pk2(s[6 * 33], s[7 * 33]);
        *(u32x4*)(WT + (size_t)(dst_row0 + n) * Kdst + kdst0 + 8 * c) = o; }
    LDS_WAIT(); asm volatile("" ::: "memory");
}
constexpr int CV_GU = 16 * 88, CV_D = 44 * 32, CV_IN = 16 * 88, CV_OUT = 12 * 32, CV_ST = 2 * CV_GU + CV_D, CV_L = CV_IN + CV_OUT;
DI void conv_items(const Args& a, LAS unsigned char* lds, int lo, int hi, int gw, int NGW, int lane, int wave) {
    unsigned char* ws = a.ws; LAS float* scr = (LAS float*)(lds + wave * 16384);
    for (int it = lo + gw; it < hi; it += NGW) {
        int r = it;
        if (r < 4 * CV_ST) {
            const int st = r / CV_ST; r -= st * CV_ST; const int l = st >> 1, f2 = st & 1;
            const float* gain = a.in[f2 ? 24 : 6] + l * D;
            if (r < 2 * CV_GU) {
                const int up = r >= CV_GU; if (up) r -= CV_GU;
                const float* W = a.in[(f2 ? 25 : 7) + up] + (size_t)l * D * DFF;
                const int kb = r / 88, nb = r % 88, n0 = nb * 32;
                transpose_item(W, DFF, D, gain, (bf16*)(ws + WS_WGU + st * SZ_WGU), (n0 >> 7) * 256 + (n0 & 127) + up * 128, kb * 64, scr, kb * 64, n0, lane);
            } else {
                r -= 2 * CV_GU;
                const float* W = a.in[f2 ? 27 : 9] + (size_t)l * DFF * D;
                const int kb = r / 32, nb = r % 32;
                transpose_item(W, D, DFF, nullptr, (bf16*)(ws + WS_WD + st * SZ_WD), nb * 32, kb * 64, scr, kb * 64, nb * 32, lane);
            }
        } else {
            r -= 4 * CV_ST; const int l = r / CV_L; r -= l * CV_L;
            if (r < CV_IN) {
                const int kb = r / 88, nb = r % 88;
                transpose_item(a.in[11] + (size_t)l * D * INW, INW, D, a.in[10] + l * D, (bf16*)(ws + WS_WIN + l * SZ_WIN), nb * 32, kb * 64, scr, kb * 64, nb * 32, lane);
            } else {
                r -= CV_IN; const int kb = 4 + r / 32, nb = r % 32;
                transpose_item(a.in[23] + (size_t)l * D * D, D, D, nullptr, (bf16*)(ws + WS_WOUT + l * SZ_WOUT), nb * 32, kb * 64, scr, kb * 64, nb * 32, lane);
            }
        }
    }
}
DI void conv_fold(const Args& a, int l, int gt, int NGT) {
    for (int idx = gt; idx < 256 * 1024; idx += NGT) {
        const int n = idx & 1023, k = idx >> 10, g = k >> 6;
        const float* pw = a.in[12] + ((size_t)l * 256 + k) * 64; const float* sc = a.in[13] + l * 256 + g * 64; const float* wo = a.in[23] + (size_t)l * D * D + (size_t)(g * 64) * D + n;
        float s = 0.f;
#pragma unroll 8
        for (int d = 0; d < 64; ++d) s += pw[d] * sc[d] * wo[(size_t)d * D];
        ((bf16*)(a.ws + WS_WOUT + l * SZ_WOUT))[(size_t)n * D + k] = (bf16)f2bf(s);
    }
}
DI void tail_convert(const Args& a, LAS unsigned char* lds, int lo1, int hi1, int lo2, int hi2, int fold_l, int T, int G, int bid) {
    if (bid < T || hi1 <= lo1) return;
    int tid_ = threadIdx.x; asm volatile("" : "+v"(tid_));
    const int tid = tid_, lane = tid & 63, wave = tid >> 6, nb = G - T, b = bid - T;
    conv_items(a, lds, lo1, hi1, b * 8 + wave, nb * 8, lane, wave);
    if (hi2 > lo2) conv_items(a, lds, lo2, hi2, b * 8 + wave, nb * 8, lane, wave);
    if (fold_l >= 0) conv_fold(a, fold_l, b * NT + tid, nb * NT);
}
DI void p0_prologue(const Args& a, LAS unsigned char* lds) {
    int tid_ = threadIdx.x; asm volatile("" : "+v"(tid_));
    const int tid = tid_, lane = tid & 63, wave = tid >> 6;
    const int obid = opaque_bid(); const int gw = obid * 8 + wave, NGW = opaque_i(gridDim.x * 8);
    unsigned char* ws = a.ws;
    conv_items(a, lds, 0, 2 * CV_GU, gw, NGW, lane, wave);
    const int gt = obid * NT + tid, NGT = opaque_i(gridDim.x * NT);
    for (int idx = gt; idx < 2 * 2 * 4 * 4096; idx += NGT) {
        const int c = idx & 63, d = (idx >> 6) & 63, g = (idx >> 12) & 3, gate = (idx >> 14) & 1, l = idx >> 15;
        ((bf16*)(ws + WS_WG))[idx] = (bf16)f2bf(a.in[gate ? 18 : 16][((size_t)(l * 4 + g) * 64 + c) * 64 + d]);
    }
    for (int k = gt; k < 512; k += NGT) {
        const float l0 = a.in[21][k], l1 = a.in[21][512 + k], mx = fmaxf(l0, l1), e0 = fexp(l0 - mx), e1 = fexp(l1 - mx), p0 = e0 / (e0 + e1), p1 = e1 / (e0 + e1);
        float* LB = (float*)(ws + WS_LB); LB[k] = fmaxf(p0 - p0, 0.f); LB[512 + k] = fmaxf((p0 + p1) - p0, 0.f);
    }
    bf16* XB = (bf16*)(ws + WS_XB); float* SSQ = (float*)(ws + WS_SSQ);
    for (int m0 = gw; m0 < M; m0 += 4 * NGW) {
        f32x4 v[4][4];
#pragma unroll
        for (int q = 0; q < 4; ++q) { const int m = (m0 + q * NGW < M) ? m0 + q * NGW : m0;
            const float* xr = (m < MP) ? a.in[0] + (size_t)m * D : a.in[1] + (size_t)(m - MP) * D;
#pragma unroll
            for (int j = 0; j < 4; ++j) v[q][j] = ((const f32x4*)xr)[64 * j + lane]; }
#pragma unroll
        for (int q = 0; q < 4; ++q) { const int m = m0 + q * NGW;
            if (m < M) { float s = 0.f;
#pragma unroll
                for (int j = 0; j < 4; ++j) { u32x2 o; o.x = pk2(v[q][j].x, v[q][j].y); o.y = pk2(v[q][j].z, v[q][j].w); ((u32x2*)(XB + (size_t)m * D))[64 * j + lane] = o;
                    const float r0 = __uint_as_float(o.x << 16), r1 = __uint_as_float(o.x & 0xffff0000u), r2 = __uint_as_float(o.y << 16), r3 = __uint_as_float(o.y & 0xffff0000u);
                    s += (r0 * r0 + r1 * r1) + (r2 * r2 + r3 * r3); }
                s = wave_sum(s);
                if (lane < 16) SSQ[(size_t)m * 16 + lane] = (lane == 0) ? s : 0.f; } }
    }
}

constexpr int L_QT = 0, L_KT = 17408, L_QH = 34816, L_VT = 52224, L_ATT = 70656, L_SEG = 79872, L_RED = 83968;
constexpr int L_CONV = 0, L_XC = 65536, L_ZX = 65536 + 33792;
constexpr int L_ZP = 0;

struct HgPre { unsigned fz[8]; unsigned q[8]; u32x4 v0, v1; };
template <bool M3> DI void hg_load(HgPre& p, const Args& a, int ci, int h, int tid) {
    const Chunk ch = get_chunk(ci); const bf16* Z = (const bf16*)(a.ws + WS_HZ);
    const bf16* zp = Z + (size_t)(ch.row0 + 8 * (tid >> 6)) * INW + h * 128 + 2 * (tid & 63);
#pragma unroll
    for (int i = 0; i < 8; ++i) p.fz[i] = *(const unsigned*)(zp + ZC_F + i * INW);
    if (M3) {
#pragma unroll
        for (int i = 0; i < 8; ++i) p.q[i] = *(const unsigned*)(zp + ZC_Q + i * INW);
    }
    { const u32x4* pv = (const u32x4*)(Z + (size_t)(ch.row0 + (tid & 63)) * INW + ZC_V + h * 128 + (tid >> 6) * 16); p.v0 = pv[0]; p.v1 = pv[1]; }
}
#define HG_LOAD_F()                                                                                                   \
    const int kp = tid & 63, sg = tid >> 6;
#define HG_CUMSUM()                                                                                                   \
    const f32x2 lb2 = *(const f32x2*)(LB + l * 512 + h * 128 + 2 * kp); const float oml0 = 1.f - lb2[0], oml1 = 1.f - lb2[1];   \
    float bc0[8], bc1[8], kk0[8], kk1[8];                                                                             \
    { float run0 = 0.f, run1 = 0.f;                                                                                   \
      _Pragma("unroll") for (int i = 0; i < 8; ++i) { const bool ok = FULL || (8 * sg + i) < ch.nv;                  \
          const float s0 = sigm(__uint_as_float(p.fz[i] << 16)), s1 = sigm(__uint_as_float(p.fz[i] & 0xffff0000u));  \
          const float lf0 = __logf(fmaxf(lb2[0] + oml0 * s0, 1e-30f)), lf1 = __logf(fmaxf(lb2[1] + oml1 * s1, 1e-30f)); \
          run0 += ok ? lf0 : 0.f; run1 += ok ? lf1 : 0.f; bc0[i] = run0; bc1[i] = run1;                               \
          kk0[i] = ok ? oml0 * (1.f - s0) : 0.f; kk1[i] = ok ? oml1 * (1.f - s1) : 0.f; }                             \
      *(LAS f32x2*)(SEG + sg * 128 + 2 * kp) = (f32x2){run0, run1}; }                                                 \
    BAR_LDS();                                                                                                        \
    float boff0 = 0.f, boff1 = 0.f, bref0 = 0.f, bref1 = 0.f, blast0 = 0.f, blast1 = 0.f;                             \
    _Pragma("unroll") for (int s_ = 0; s_ < 8; ++s_) { const f32x2 sv = *(const LAS f32x2*)(SEG + s_ * 128 + 2 * kp); \
        if (s_ < sg) { boff0 += sv[0]; boff1 += sv[1]; } if (s_ < 4) { bref0 += sv[0]; bref1 += sv[1]; } blast0 += sv[0]; blast1 += sv[1]; }   \
    _Pragma("unroll") for (int i = 0; i < 8; ++i) { bc0[i] += boff0; bc1[i] += boff1; }

#define HG_STORE_VT()                                                                                                 \
    { const int s = tid & 63, vb = tid >> 6; const bool ok = FULL || s < ch.nv;                                       \
      const u32x4 w0 = ok ? p.v0 : (u32x4){0u, 0u, 0u, 0u}, w1 = ok ? p.v1 : (u32x4){0u, 0u, 0u, 0u};                 \
      LAS bf16* vt = VT + (vb * 16) * 72 + s;                                                                         \
      _Pragma("unroll") for (int i = 0; i < 4; ++i) { vt[(2 * i) * 72] = (bf16)(w0[i] & 0xffffu); vt[(2 * i + 1) * 72] = (bf16)(w0[i] >> 16);   \
          vt[(8 + 2 * i) * 72] = (bf16)(w1[i] & 0xffffu); vt[(8 + 2 * i + 1) * 72] = (bf16)(w1[i] >> 16); } }

template <bool FULL> DI void m1_lru_unit(const Args& a, LAS unsigned char* lds, int l, int ci) {
    int tid_ = threadIdx.x; asm volatile("" : "+v"(tid_));
    const int tid = tid_, lane = tid & 63, wave = tid >> 6;
    const Chunk ch = get_chunk(ci);
    const bf16* Z = (const bf16*)(a.ws + WS_HZ);
    LAS float* CONV = (LAS float*)(lds + L_CONV); LAS bf16* XC = (LAS bf16*)(lds + L_XC);
    {
        LAS bf16* ZX = (LAS bf16*)(lds + L_ZX);
        const bool hist_z = (!ch.smp && ch.cis > 0);
        {
            u32x4 v[5];
#pragma unroll
            for (int it = 0; it < 5; ++it) { const int idx = tid + it * NT, rr = idx >> 5, pc = idx & 31, tp = rr - 3;
                const bool use_z = (idx < ((FULL ? 64 : ch.nv) + 3) * 32) && (tp >= 0 || hist_z);
                v[it] = *(const u32x4*)(Z + (size_t)(ch.row0 + (use_z ? tp : 0)) * INW + ZC_XB + pc * 8);
                if (!use_z) v[it] = (u32x4){0u, 0u, 0u, 0u}; }
#pragma unroll
            for (int it = 0; it < 5; ++it) { const int idx = tid + it * NT, rr = idx >> 5, pc = idx & 31, tp = rr - 3;
                if (idx < ((FULL ? 64 : ch.nv) + 3) * 32) {
                    u32x4 x = v[it];
                    if (!FULL && ch.smp && tp < 0) { const f32x4* p = (const f32x4*)(a.in[3] + ((size_t)(l * 32 + ch.b) * 3 + (3 + tp)) * 256 + pc * 8); const f32x4 p0 = p[0], p1 = p[1];
                        x.x = pk2(p0[0], p0[1]); x.y = pk2(p0[2], p0[3]); x.z = pk2(p1[0], p1[1]); x.w = pk2(p1[2], p1[3]); }
                    *(LAS u32x4*)(ZX + rr * 256 + pc * 8) = x; } }
        }
        const int c4 = (tid & 63) * 4, tq = tid >> 6;
        const f32x4 w0 = *(const f32x4*)(a.in[14] + (l * 4 + 0) * 256 + c4), w1 = *(const f32x4*)(a.in[14] + (l * 4 + 1) * 256 + c4), w2 = *(const f32x4*)(a.in[14] + (l * 4 + 2) * 256 + c4),
                    w3 = *(const f32x4*)(a.in[14] + (l * 4 + 3) * 256 + c4), cb = *(const f32x4*)(a.in[15] + l * 256 + c4);
        BAR_LDS();
#pragma unroll
        for (int i = 0; i < 8; ++i) { const int t = tq + 8 * i;
            if (FULL || t < ch.nv) {
                f32x4 cv = cb;
#pragma unroll
                for (int k = 0; k < 4; ++k) { const u32x2 x = *(const LAS u32x2*)(ZX + (t + k) * 256 + c4); const f32x4 wk = (k == 0) ? w0 : (k == 1) ? w1 : (k == 2) ? w2 : w3;
                    cv[0] += wk[0] * __uint_as_float(x.x << 16); cv[1] += wk[1] * __uint_as_float(x.x & 0xffff0000u); cv[2] += wk[2] * __uint_as_float(x.y << 16); cv[3] += wk[3] * __uint_as_float(x.y & 0xffff0000u); }
                *(LAS f32x4*)(CONV + t * 256 + c4) = cv; u32x2 o; o.x = pk2(cv[0], cv[1]); o.y = pk2(cv[2], cv[3]); *(LAS u32x2*)(XC + t * 264 + c4) = o;
            } }
    }
    const int g = wave & 3, dh = wave >> 2, quad = lane >> 4, l15 = lane & 15;
    bf16x8 Ba[2][2], Bx[2][2];
    {
        const bf16* wg = (const bf16*)(a.ws + WS_WG) + (size_t)((l * 2) * 4 + g) * 4096 + (dh * 32 + l15) * 64 + quad * 8;
#pragma unroll
        for (int nt = 0; nt < 2; ++nt)
#pragma unroll
            for (int ks = 0; ks < 2; ++ks) { Ba[nt][ks] = *(const bf16x8*)(wg + nt * 1024 + ks * 32); Bx[nt][ks] = *(const bf16x8*)(wg + 4 * 4096 + nt * 1024 + ks * 32); }
    }
    BAR_LDS();
    f32x4 accA[4][2], accX[4][2];
#pragma unroll
    for (int mt = 0; mt < 4; ++mt)
#pragma unroll
        for (int nt = 0; nt < 2; ++nt) { accA[mt][nt] = (f32x4){0.f, 0.f, 0.f, 0.f}; accX[mt][nt] = (f32x4){0.f, 0.f, 0.f, 0.f}; }
#pragma unroll
    for (int mt = 0; mt < 4; ++mt)
#pragma unroll
        for (int ks = 0; ks < 2; ++ks) {
            const bf16x8 af = *(const LAS bf16x8*)(XC + (mt * 16 + l15) * 264 + g * 64 + ks * 32 + quad * 8);
#pragma unroll
            for (int nt = 0; nt < 2; ++nt) { accA[mt][nt] = mfma16(af, Ba[nt][ks], accA[mt][nt]); accX[mt][nt] = mfma16(af, Bx[nt][ks], accX[mt][nt]); }
        }
    float* HL = (float*)(a.ws + WS_HL); float* PP = (float*)(a.ws + WS_PP);
#pragma unroll
    for (int nt = 0; nt < 2; ++nt) {
        const int c = g * 64 + dh * 32 + nt * 16 + l15;
        const float ba = a.in[17][l * 256 + c], bx = a.in[19][l * 256 + c], lam = a.in[20][l * 256 + c];
        const float spc = -8.f * log1pf(fexp(-lam));
        float carryH = 0.f, carryP = 1.f;
#pragma unroll
        for (int mt = 0; mt < 4; ++mt) {
            float hl[4], pl[4]; float hh = 0.f, pp = 1.f;
#pragma unroll
            for (int j = 0; j < 4; ++j) {
                const int t = mt * 16 + quad * 4 + j;
                float av = 1.f, bt = 0.f;
                if (FULL || t < ch.nv) {
                    const float r = sigm(accA[mt][nt][j] + ba), ig = sigm(accX[mt][nt][j] + bx);
                    const float la = spc * r; av = fexp(la);
                    float mult = __builtin_amdgcn_sqrtf(fmaxf(1.f - av * av, 0.f));
                    if (!ch.smp && ch.cis == 0 && t == 0) mult = 1.f;
                    bt = mult * (ig * CONV[t * 256 + c]);
                }
                hh = av * hh + bt; pp = pp * av; hl[j] = hh; pl[j] = pp;
            }
            float sa[4], sb[4];
#pragma unroll
            for (int q = 0; q < 4; ++q) { sa[q] = __shfl(pp, l15 + 16 * q); sb[q] = __shfl(hh, l15 + 16 * q); }
            float H0 = carryH, P0 = carryP;
#pragma unroll
            for (int q = 0; q < 3; ++q) if (q < quad) { H0 = sa[q] * H0 + sb[q]; P0 = P0 * sa[q]; }
#pragma unroll
            for (int j = 0; j < 4; ++j) { const int t = mt * 16 + quad * 4 + j;
                if (FULL || t < ch.nv) { const size_t o = (size_t)(ch.row0 + t) * 256 + c; HL[o] = hl[j] + pl[j] * H0; PP[o] = pl[j] * P0; } }
#pragma unroll
            for (int q = 0; q < 4; ++q) { carryH = sa[q] * carryH + sb[q]; carryP = carryP * sa[q]; }
        }
    }
    BAR_LDS();
}

template <bool FULL> DI void m1_hgrn_unit(const HgPre& p, const Args& a, LAS unsigned char* lds, int l, int ci, int h, int tid) {
    const int lane = tid & 63, wave = tid >> 6;
    const Chunk ch = get_chunk(ci);
    const bf16* Z = (const bf16*)(a.ws + WS_HZ); const float* LB = (const float*)(a.ws + WS_LB);
    LAS bf16* KT = (LAS bf16*)(lds + L_KT); LAS bf16* VT = (LAS bf16*)(lds + L_VT); LAS float* SEG = (LAS float*)(lds + L_SEG);
    HG_LOAD_F();
    HG_CUMSUM();
    (void)bref0; (void)bref1;
    {
        u32x4 w0, w1;
#pragma unroll
        for (int i = 0; i < 4; ++i) { w0[i] = pk2(kk0[2 * i] * fexp(blast0 - bc0[2 * i]), kk0[2 * i + 1] * fexp(blast0 - bc0[2 * i + 1]));
                                      w1[i] = pk2(kk1[2 * i] * fexp(blast1 - bc1[2 * i]), kk1[2 * i + 1] * fexp(blast1 - bc1[2 * i + 1])); }
        *(LAS u32x4*)(KT + (2 * kp) * 72 + sg * 8) = w0; *(LAS u32x4*)(KT + (2 * kp + 1) * 72 + sg * 8) = w1;
        if (sg == 0) *(f32x2*)((float*)(a.ws + WS_DEC) + (size_t)(ci * 4 + h) * 128 + 2 * kp) = (f32x2){fexp(blast0), fexp(blast1)};
    }
    HG_STORE_VT();
    BAR_LDS();
    const int quad = lane >> 4, l15 = lane & 15;
    bf16x8 af[2];
#pragma unroll
    for (int ks = 0; ks < 2; ++ks) af[ks] = *(const LAS bf16x8*)(KT + (wave * 16 + l15) * 72 + ks * 32 + quad * 8);
    bf16* UT = (bf16*)(a.ws + WS_US) + (size_t)(ci * 4 + h) * 16384;
#pragma unroll
    for (int vt = 0; vt < 8; ++vt) {
        f32x4 acc = (f32x4){0.f, 0.f, 0.f, 0.f};
#pragma unroll
        for (int ks = 0; ks < 2; ++ks) { const bf16x8 bfr = *(const LAS bf16x8*)(VT + (vt * 16 + l15) * 72 + ks * 32 + quad * 8); acc = mfma16(af[ks], bfr, acc); }
        u32x2 o; o.x = pk2(acc[0], acc[1]); o.y = pk2(acc[2], acc[3]);
        *(u32x2*)(UT + (vt * 16 + l15) * 128 + wave * 16 + quad * 4) = o;
    }
    BAR_LDS();
}

DI void m2_scan(const Args& a, int l) {
    int tid_ = threadIdx.x; asm volatile("" : "+v"(tid_));
    const int gt = opaque_bid() * NT + tid_, NGT = opaque_i(gridDim.x * NT);
    bf16* US = (bf16*)(a.ws + WS_US); const float* DEC = (const float*)(a.ws + WS_DEC);
    const bf16* Z = (const bf16*)(a.ws + WS_HZ);
    for (int it = gt; it < 32 * 4096; it += NGT) {
        const int bh = it >> 12, e = (it & 4095) * 4, b = bh >> 2, h = bh & 3, k = e & 127, v = e >> 7;
        f32x4 S = (f32x4){0.f, 0.f, 0.f, 0.f};
        u32x2 un[8]; f32x4 dn[8];
#pragma unroll
        for (int j = 0; j < 8; ++j) { const size_t cu = (size_t)((b * 128 + j) * 4 + h); un[j] = *(const u32x2*)(US + cu * 16384 + e); dn[j] = *(const f32x4*)(DEC + cu * 128 + k); }
        for (int c0 = 0; c0 < 128; c0 += 8) {
            u32x2 u[8]; f32x4 d[8];
#pragma unroll
            for (int j = 0; j < 8; ++j) { u[j] = un[j]; d[j] = dn[j]; }
            if (c0 + 8 < 128) {
#pragma unroll
                for (int j = 0; j < 8; ++j) { const size_t cu = (size_t)((b * 128 + c0 + 8 + j) * 4 + h); un[j] = *(const u32x2*)(US + cu * 16384 + e); dn[j] = *(const f32x4*)(DEC + cu * 128 + k); }
            }
#pragma unroll
            for (int j = 0; j < 8; ++j) { const size_t cu = (size_t)((b * 128 + c0 + j) * 4 + h);
                u32x2 o; o.x = pk2(S[0], S[1]); o.y = pk2(S[2], S[3]); *(u32x2*)(US + cu * 16384 + e) = o;
                S[0] = d[j][0] * S[0] + __uint_as_float(u[j].x << 16); S[1] = d[j][1] * S[1] + __uint_as_float(u[j].x & 0xffff0000u);
                S[2] = d[j][2] * S[2] + __uint_as_float(u[j].y << 16); S[3] = d[j][3] * S[3] + __uint_as_float(u[j].y & 0xffff0000u); }
        }
        float* o = a.out + O_HGP + ((size_t)((l * 8 + b) * 4 + h)) * 16384 + v;
#pragma unroll
        for (int j = 0; j < 4; ++j) o[(size_t)(k + j) * 128] = S[j];
    }
    for (int it = gt; it < 128 * 4096; it += NGT) {
        const int bh = it >> 12, e = (it & 4095) * 4, b = bh >> 2, h = bh & 3, k = e & 127, v = e >> 7;
        const float* s0 = a.in[5] + ((size_t)((l * 32 + b) * 4 + h)) * 16384 + v;
        const size_t cu = (size_t)((NCH_P + b) * 4 + h);
        const u32x2 u = *(const u32x2*)(US + cu * 16384 + e); const f32x4 d = *(const f32x4*)(DEC + cu * 128 + k);
        f32x4 S;
#pragma unroll
        for (int j = 0; j < 4; ++j) S[j] = s0[(size_t)(k + j) * 128];
        u32x2 ob; ob.x = pk2(S[0], S[1]); ob.y = pk2(S[2], S[3]); *(u32x2*)(US + cu * 16384 + e) = ob;
        S[0] = d[0] * S[0] + __uint_as_float(u.x << 16); S[1] = d[1] * S[1] + __uint_as_float(u.x & 0xffff0000u);
        S[2] = d[2] * S[2] + __uint_as_float(u.y << 16); S[3] = d[3] * S[3] + __uint_as_float(u.y & 0xffff0000u);
        float* o = a.out + O_HGS + ((size_t)((l * 32 + b) * 4 + h)) * 16384 + v;
#pragma unroll
        for (int j = 0; j < 4; ++j) o[(size_t)(k + j) * 128] = S[j];
    }
    const float* HL = (const float*)(a.ws + WS_HL); const float* PP = (const float*)(a.ws + WS_PP); float* CARRY = (float*)(a.ws + WS_CARRY);
    for (int it = NGT - 1 - gt; it < 2048 + 8192; it += NGT) {
        if (it < 2048) { const int b = it >> 8, c = it & 255; float hcar = 0.f;
            for (int c0 = 0; c0 < 128; c0 += 32) { float p[32], q[32];
#pragma unroll
                for (int j = 0; j < 32; ++j) { const size_t o = (size_t)(b * 8192 + (c0 + j) * 64 + 63) * 256 + c; p[j] = PP[o]; q[j] = HL[o]; }
#pragma unroll
                for (int j = 0; j < 32; ++j) { CARRY[(size_t)(b * 128 + c0 + j) * 256 + c] = hcar; hcar = p[j] * hcar + q[j]; } }
            a.out[O_LRUP + (size_t)(l * 8 + b) * 256 + c] = hcar;
        } else { const int i2 = it - 2048, b = i2 >> 8, c = i2 & 255; const float h0 = a.in[4][(size_t)(l * 32 + b) * 256 + c];
            const size_t o = (size_t)(MP + b * 16 + 15) * 256 + c; CARRY[(size_t)(NCH_P + b) * 256 + c] = h0; a.out[O_LRUS + (size_t)(l * 32 + b) * 256 + c] = PP[o] * h0 + HL[o]; }
    }
    for (int it = gt; it < 8 * 15 * 256; it += NGT) { const int c = it & 255, j = (it >> 8) % 15, b = it / (15 * 256); a.out[O_POOLP + (size_t)l * 8 * 15 * 256 + it] = bf2f(Z[(size_t)(b * 8192 + 8177 + j) * INW + ZC_POOL + c]); }
    for (int it = gt; it < 8 * 3 * 256; it += NGT) { const int c = it & 255, j = (it >> 8) % 3, b = it / (3 * 256); a.out[O_CONVP + (size_t)l * 8 * 3 * 256 + it] = bf2f(Z[(size_t)(b * 8192 + 8189 + j) * INW + ZC_XB + c]); }
    for (int it = gt; it < 32 * 15 * 256; it += NGT) { const int c = it & 255, j = (it >> 8) % 15, b = it / (15 * 256); a.out[O_POOLS + (size_t)l * 32 * 15 * 256 + it] = bf2f(Z[(size_t)(MP + b * 16 + 1 + j) * INW + ZC_POOL + c]); }
    for (int it = gt; it < 32 * 3 * 256; it += NGT) { const int c = it & 255, j = (it >> 8) % 3, b = it / (3 * 256); a.out[O_CONVS + (size_t)l * 32 * 3 * 256 + it] = bf2f(Z[(size_t)(MP + b * 16 + 13 + j) * INW + ZC_XB + c]); }
}

template <bool FULL> DI void m3_elem_unit(const Args& a, LAS unsigned char* lds, int l, int ci) {
    int tid_ = threadIdx.x; asm volatile("" : "+v"(tid_));
    const int tid = tid_, lane = tid & 63, wave = tid >> 6; const Chunk ch = get_chunk(ci);
    const bf16* Z = (const bf16*)(a.ws + WS_HZ); bf16* MIX = (bf16*)(a.ws + WS_MIX);
    LAS bf16* ZP = (LAS bf16*)(lds + L_ZP);
    const bool hist_z = (!ch.smp && ch.cis > 0);
    {
        u32x4 v[5];
#pragma unroll
        for (int it = 0; it < 5; ++it) { const int idx = tid + it * NT, rr = idx >> 5, pc = idx & 31, tp = rr - 15;
            const bool use_z = (idx < ((FULL ? 64 : ch.nv) + 15) * 32) && (tp >= 0 || hist_z);
            v[it] = *(const u32x4*)(Z + (size_t)(ch.row0 + (use_z ? tp : 0)) * INW + ZC_POOL + pc * 8);
            if (!use_z) v[it] = (u32x4){0u, 0u, 0u, 0u}; }
#pragma unroll
        for (int it = 0; it < 5; ++it) { const int idx = tid + it * NT, rr = idx >> 5, pc = idx & 31, tp = rr - 15;
            if (idx < ((FULL ? 64 : ch.nv) + 15) * 32) {
                u32x4 x = v[it];
                if (!FULL && ch.smp && tp < 0) { const f32x4* p = (const f32x4*)(a.in[2] + ((size_t)(l * 32 + ch.b) * 15 + (15 + tp)) * 256 + pc * 8); const f32x4 p0 = p[0], p1 = p[1];
                    x.x = pk2(p0[0], p0[1]); x.y = pk2(p0[2], p0[3]); x.z = pk2(p1[0], p1[1]); x.w = pk2(p1[2], p1[3]); }
                *(LAS u32x4*)(ZP + rr * 256 + pc * 8) = x; } }
    }
    const int grp = wave & 3, c4 = grp * 64 + (lane & 15) * 4, tq = (lane >> 4) + 4 * (wave >> 2);
    {
        const float* HL = (const float*)(a.ws + WS_HL); const float* PP = (const float*)(a.ws + WS_PP);
        const f32x4 car = *(const f32x4*)((const float*)(a.ws + WS_CARRY) + (size_t)ci * 256 + c4);
#pragma unroll
        for (int i = 0; i < 8; ++i) { const int t = tq + 8 * i;
            if (FULL || t < ch.nv) { const size_t r = ch.row0 + t; const f32x4 hl = *(const f32x4*)(HL + r * 256 + c4), pp = *(const f32x4*)(PP + r * 256 + c4); const u32x2 gz = *(const u32x2*)(Z + r * INW + ZC_GB + c4);
                const f32x4 hv = hl + pp * car;
                u32x2 o; o.x = pk2(hv[0] * gelu_tanh(__uint_as_float(gz.x << 16)), hv[1] * gelu_tanh(__uint_as_float(gz.x & 0xffff0000u)));
                o.y = pk2(hv[2] * gelu_tanh(__uint_as_float(gz.y << 16)), hv[3] * gelu_tanh(__uint_as_float(gz.y & 0xffff0000u)));
                *(u32x2*)(MIX + r * D + 256 + c4) = o; } }
    }
    BAR_LDS();
    {
        const int win = 2 << grp; const int pos0 = ch.smp ? 2048 : ch.cis * 64;
#pragma unroll
        for (int i = 0; i < 8; ++i) { const int t = tq + 8 * i;
            if (FULL || t < ch.nv) {
                f32x4 sm = (f32x4){0.f, 0.f, 0.f, 0.f};
                for (int j = 0; j < win; ++j) { const u32x2 x = *(const LAS u32x2*)(ZP + (t + 15 - j) * 256 + c4);
                    sm[0] += __uint_as_float(x.x << 16); sm[1] += __uint_as_float(x.x & 0xffff0000u); sm[2] += __uint_as_float(x.y << 16); sm[3] += __uint_as_float(x.y & 0xffff0000u); }
                const u32x2 x = *(const LAS u32x2*)(ZP + (t + 15) * 256 + c4);
                const int pos = pos0 + t; const float ic = frcp((float)((pos + 1 < win) ? pos + 1 : win));
                u32x2 o; o.x = pk2(sm[0] * ic - __uint_as_float(x.x << 16), sm[1] * ic - __uint_as_float(x.x & 0xffff0000u)); o.y = pk2(sm[2] * ic - __uint_as_float(x.y << 16), sm[3] * ic - __uint_as_float(x.y & 0xffff0000u));
                *(u32x2*)(MIX + (size_t)(ch.row0 + t) * D + c4) = o;
            } }
    }
    BAR_LDS();
}

template <bool FULL> DI void m3_hgrn_unit(const HgPre& p, const Args& a, LAS unsigned char* lds, int l, int ci, int h, int tid) {
    const int lane = tid & 63, wave = tid >> 6;
    const Chunk ch = get_chunk(ci);
    const bf16* Z = (const bf16*)(a.ws + WS_HZ); const float* LB = (const float*)(a.ws + WS_LB);
    LAS bf16* QT = (LAS bf16*)(lds + L_QT); LAS bf16* KT = (LAS bf16*)(lds + L_KT); LAS bf16* QH = (LAS bf16*)(lds + L_QH); LAS bf16* VT = (LAS bf16*)(lds + L_VT);
    LAS bf16* ATT = (LAS bf16*)(lds + L_ATT); LAS float* SEG = (LAS float*)(lds + L_SEG); LAS float* RED = (LAS float*)(lds + L_RED);
    const int quad = lane >> 4, l15 = lane & 15, v0 = wave * 16 + quad * 4;
    HG_LOAD_F();
    const f32x4 ng = *(const f32x4*)(a.in[22] + l * 512 + h * 128 + v0);
    bf16x8 sf[4]; u32x2 gzr[4];
    { const bf16* ST = (const bf16*)(a.ws + WS_US) + (size_t)(ci * 4 + h) * 16384 + (wave * 16 + l15) * 128 + quad * 8;
#pragma unroll
      for (int ks = 0; ks < 4; ++ks) sf[ks] = *(const bf16x8*)(ST + ks * 32);
#pragma unroll
      for (int tt = 0; tt < 4; ++tt) { const int t = tt * 16 + l15; gzr[tt] = (FULL || t < ch.nv) ? *(const u32x2*)(Z + (size_t)(ch.row0 + t) * INW + ZC_G + h * 128 + v0) : (u32x2){0u, 0u}; } }
    HG_CUMSUM();
    (void)blast0; (void)blast1;
    {
        const float eb0 = fexp(bref0), eb1 = fexp(bref1);
#pragma unroll
        for (int i = 0; i < 8; ++i) { const int t = sg * 8 + i; const bool ok = FULL || t < ch.nv;
            const float q0 = ok ? siluf(__uint_as_float(p.q[i] << 16)) : 0.f, q1 = ok ? siluf(__uint_as_float(p.q[i] & 0xffff0000u)) : 0.f;
            const float d0 = clampf(bc0[i] - bref0, -80.f, 80.f), d1 = clampf(bc1[i] - bref1, -80.f, 80.f);
            const float e0 = fexp(d0), e1 = fexp(d1), qe0 = q0 * e0, qe1 = q1 * e1;
            *(LAS unsigned*)(QT + t * 136 + 2 * kp) = pk2(qe0, qe1);
            *(LAS unsigned*)(KT + t * 136 + 2 * kp) = pk2(kk0[i] * frcp(e0), kk1[i] * frcp(e1));
            *(LAS unsigned*)(QH + t * 136 + 2 * kp) = pk2(qe0 * eb0, qe1 * eb1); }
    }
    HG_STORE_VT();
    BAR_LDS();
#pragma unroll
    for (int x = 0; x < 2; ++x) {
        const int idx = wave * 2 + x, tt = idx >> 2, st = idx & 3;
        f32x4 acc = (f32x4){0.f, 0.f, 0.f, 0.f};
        if (st <= tt) {
#pragma unroll
            for (int ks = 0; ks < 4; ++ks) { const bf16x8 af = *(const LAS bf16x8*)(KT + (st * 16 + l15) * 136 + ks * 32 + quad * 8); const bf16x8 bfr = *(const LAS bf16x8*)(QT + (tt * 16 + l15) * 136 + ks * 32 + quad * 8); acc = mfma16(af, bfr, acc); }
        }
        const int t = tt * 16 + l15, s0 = st * 16 + quad * 4;
        u32x2 o; o.x = pk2(s0 <= t ? acc[0] : 0.f, s0 + 1 <= t ? acc[1] : 0.f); o.y = pk2(s0 + 2 <= t ? acc[2] : 0.f, s0 + 3 <= t ? acc[3] : 0.f);
        *(LAS u32x2*)(ATT + t * 72 + s0) = o;
    }
    f32x4 oacc[4];
#pragma unroll
    for (int tt = 0; tt < 4; ++tt) oacc[tt] = (f32x4){0.f, 0.f, 0.f, 0.f};
    {
#pragma unroll
        for (int tt = 0; tt < 4; ++tt)
#pragma unroll
            for (int ks = 0; ks < 4; ++ks) { const bf16x8 bfr = *(const LAS bf16x8*)(QH + (tt * 16 + l15) * 136 + ks * 32 + quad * 8); oacc[tt] = mfma16(sf[ks], bfr, oacc[tt]); }
    }
    BAR_LDS();
    {
        bf16x8 vf[2];
#pragma unroll
        for (int ks = 0; ks < 2; ++ks) vf[ks] = *(const LAS bf16x8*)(VT + (wave * 16 + l15) * 72 + ks * 32 + quad * 8);
#pragma unroll
        for (int tt = 0; tt < 4; ++tt)
#pragma unroll
            for (int ks = 0; ks < 2; ++ks) { const bf16x8 bfr = *(const LAS bf16x8*)(ATT + (tt * 16 + l15) * 72 + ks * 32 + quad * 8); oacc[tt] = mfma16(vf[ks], bfr, oacc[tt]); }
    }
#pragma unroll
    for (int tt = 0; tt < 4; ++tt) { float s = (oacc[tt][0] * oacc[tt][0] + oacc[tt][1] * oacc[tt][1]) + (oacc[tt][2] * oacc[tt][2] + oacc[tt][3] * oacc[tt][3]);
        s += __shfl_xor(s, 16); s += __shfl_xor(s, 32); if (quad == 0) RED[wave * 64 + tt * 16 + l15] = s; }
    BAR_LDS();
    bf16* MIX = (bf16*)(a.ws + WS_MIX);
#pragma unroll
    for (int tt = 0; tt < 4; ++tt) { const int t = tt * 16 + l15;
        if (FULL || t < ch.nv) {
            float s = 0.f;
#pragma unroll
            for (int w = 0; w < 8; ++w) s += RED[w * 64 + t];
            const float rs = rsqrtf(s * (1.f / 128.f) + EPS);
            const size_t r = ch.row0 + t; const u32x2 gz = gzr[tt];
            const float g0 = siluf(__uint_as_float(gz.x << 16)), g1 = siluf(__uint_as_float(gz.x & 0xffff0000u)), g2 = siluf(__uint_as_float(gz.y << 16)), g3 = siluf(__uint_as_float(gz.y & 0xffff0000u));
            u32x2 o; o.x = pk2(oacc[tt][0] * rs * ng[0] * g0, oacc[tt][1] * rs * ng[1] * g1); o.y = pk2(oacc[tt][2] * rs * ng[2] * g2, oacc[tt][3] * rs * ng[3] * g3);
            *(u32x2*)(MIX + r * D + 512 + h * 128 + v0) = o;
        } }
    BAR_LDS();
}

DI void pf_final(const Args& a) {
    int tid_ = threadIdx.x; asm volatile("" : "+v"(tid_));
    const int lane = tid_ & 63, gw = opaque_bid() * 8 + (tid_ >> 6), NGW = opaque_i(gridDim.x * 8);
    const f32x4* fn = (const f32x4*)a.in[28]; const bf16* XB = (const bf16*)(a.ws + WS_XB); const float* SSQ = (const float*)(a.ws + WS_SSQ);
    f32x4 g[4];
#pragma unroll
    for (int j = 0; j < 4; ++j) g[j] = fn[64 * j + lane];
    for (int m0 = gw; m0 < M; m0 += 4 * NGW) {
        u32x2 x[4][4]; f32x4 p[4];
#pragma unroll
        for (int q = 0; q < 4; ++q) { const int m = (m0 + q * NGW < M) ? m0 + q * NGW : m0;
            p[q] = *(const f32x4*)(SSQ + (size_t)m * 16 + (lane & 3) * 4);
#pragma unroll
            for (int j = 0; j < 4; ++j) x[q][j] = ((const u32x2*)(XB + (size_t)m * D))[64 * j + lane]; }
#pragma unroll
        for (int q = 0; q < 4; ++q) { const int m = m0 + q * NGW;
            if (m < M) {
                float sq = (p[q][0] + p[q][1]) + (p[q][2] + p[q][3]); sq += __shfl_xor(sq, 1); sq += __shfl_xor(sq, 2);
                const float r = rsqrtf(sq * (1.f / 1024.f) + EPS);
                f32x4* yr = (f32x4*)(a.out + (size_t)m * D);
#pragma unroll
                for (int j = 0; j < 4; ++j) { f32x4 v;
                    v[0] = __uint_as_float(x[q][j].x << 16) * r * g[j][0]; v[1] = __uint_as_float(x[q][j].x & 0xffff0000u) * r * g[j][1]; v[2] = __uint_as_float(x[q][j].y << 16) * r * g[j][2]; v[3] = __uint_as_float(x[q][j].y & 0xffff0000u) * r * g[j][3];
                    yr[64 * j + lane] = v; } } }
    }
}

#define RLX_AGENT __ATOMIC_RELAXED, __HIP_MEMORY_SCOPE_AGENT
#define XB_TMO      128
#define XB_XCNT(j)  (256  + 64 * (j))
#define XB_XSUB(j)  (1280 + 64 * (j))
#define XB_XGEN(j)  (2304 + 64 * (j))
#define XB_TOP      3328
#define XB_TOPGEN   3392
#define XCD_BAR_WORDS 3456
#define XB_SPIN_CAP (1u << 18)

__device__ __forceinline__ unsigned xb_ld(unsigned* p)              { return __hip_atomic_load(p, __ATOMIC_RELAXED, __HIP_MEMORY_SCOPE_AGENT); }
__device__ __forceinline__ unsigned xb_add(unsigned* p, unsigned v) { return __hip_atomic_fetch_add(p, v, __ATOMIC_RELAXED, __HIP_MEMORY_SCOPE_AGENT); }
__device__ __forceinline__ unsigned xb_xcc_id() { return (unsigned)__builtin_amdgcn_s_getreg((3 << 11) | 20) & 0xFu; }
#define XB_SPIN(cond, bar) do { unsigned _sp = 0; while (cond) { __builtin_amdgcn_s_sleep(1); \
    if ((++_sp & 255u) == 0u) { if (xb_ld(&(bar)[XB_TMO])) break; if (_sp > XB_SPIN_CAP) { atomicAdd(&(bar)[XB_TMO], 1u); break; } } } } while (0)

struct XcdBarrier {
    unsigned* bar; unsigned x;
    volatile LAS unsigned* st;
};

__device__ __forceinline__ XcdBarrier xcd_barrier_post(unsigned* bar, volatile LAS unsigned* st) {
    XcdBarrier b; b.bar = bar; b.x = xb_xcc_id(); b.st = st;
    if (threadIdx.x == 0) (void)xb_add(&bar[XB_XCNT(b.x)], 1u);
    return b;
}
__device__ __forceinline__ void xcd_barrier_complete(unsigned* bar, unsigned x, unsigned& nloc, unsigned& nx) {
    const unsigned G = gridDim.x * gridDim.y * gridDim.z;
    unsigned sum, cnt, mine, sp = 0u;
    for (;;) {
        sum = 0u; cnt = 0u; mine = 0u;
#pragma unroll
        for (unsigned j = 0; j < 16; ++j) { const unsigned c = xb_ld(&bar[XB_XCNT(j)]); sum += c; cnt += (c > 0u) ? 1u : 0u; mine = (j == x) ? c : mine; }
        if (sum == G) break;
        __builtin_amdgcn_s_sleep(1);
        if ((++sp & 255u) == 0u) { if (xb_ld(&bar[XB_TMO])) break; if (sp > XB_SPIN_CAP) { atomicAdd(&bar[XB_TMO], 1u); break; } }
    }
    nloc = mine > 0u ? mine : 1u; nx = cnt > 0u ? cnt : 1u;
}

__device__ __forceinline__ void xcd_barrier(const XcdBarrier& b) {
    asm volatile("s_waitcnt vmcnt(0)" ::: "memory");
    __syncthreads();
    if (threadIdx.x == 0) {
        unsigned* bar = b.bar;
        __builtin_amdgcn_s_waitcnt(0);
        unsigned nloc = b.st[0], nx = b.st[1];
        if (nloc == 0u) { xcd_barrier_complete(bar, b.x, nloc, nx); b.st[0] = nloc; b.st[1] = nx; }
        const unsigned old = xb_add(&bar[XB_XSUB(b.x)], 1u);
        const unsigned gen = old / nloc;
        if (old + 1u == (gen + 1u) * nloc) {
            __builtin_amdgcn_fence(__ATOMIC_RELEASE, "agent");
            asm volatile("s_waitcnt vmcnt(0)" ::: "memory");
            const unsigned og = xb_add(&bar[XB_TOP], 1u);
            const unsigned tg = og / nx;
            if (og + 1u == (tg + 1u) * nx) xb_add(&bar[XB_TOPGEN], 1u);
            else XB_SPIN(xb_ld(&bar[XB_TOPGEN]) == tg, bar);
            __builtin_amdgcn_fence(__ATOMIC_ACQUIRE, "agent");
            xb_add(&bar[XB_XGEN(b.x)], 1u);
            asm volatile("s_waitcnt vmcnt(0)" ::: "memory");
        } else {
            XB_SPIN(xb_ld(&bar[XB_XGEN(b.x)]) == gen, bar);
            __builtin_amdgcn_fence(__ATOMIC_ACQUIRE, "agent");
            asm volatile("s_waitcnt vmcnt(0)" ::: "memory");
        }
    }
    __syncthreads();
}

__global__ void __launch_bounds__(NT, 2) fwd_kernel(Args a) {
    extern __shared__ __attribute__((aligned(16))) unsigned char lds_raw[];
    LAS unsigned char* lds = (LAS unsigned char*)lds_raw;
    cg::grid_group grid = cg::this_grid();
    unsigned char* ws = a.ws;
    const int G = gridDim.x, bid = blockIdx.x;
    int ph = 0;
    volatile LAS unsigned* bst = (volatile LAS unsigned*)(lds + LDS_BYTES - 64);
    unsigned* barw = (unsigned*)(ws + WS_BAR);
    XcdBarrier xbar; xbar.bar = barw; xbar.x = 0; xbar.st = bst;
#ifndef PHMASK
#define PHMASK 0xFFFFFFFFu
#endif
#ifndef REPMASK
#define REPMASK 0u
#endif
#define PH_BEGIN(id) if (((PHMASK >> (id)) & 1u) && ph >= a.ph_lo && ph < a.ph_hi) { constexpr int NREP = ((REPMASK >> (id)) & 1u) ? 2 : 1; for (int rep = 0; rep < NREP; ++rep) { const bool dummy = (rep + 1 < NREP); if (rep > 0) xcd_barrier(xbar);
#define PH_END   } if (ph + 1 < a.ph_hi) xcd_barrier(xbar); } ++ph;
    {
        if (ph >= a.ph_lo && ph < a.ph_hi) {
            if (bid == 0) for (int i = threadIdx.x; i < XCD_BAR_WORDS; i += NT) __hip_atomic_store(barw + i, 0u, RLX_AGENT);
            if (threadIdx.x < 2) bst[threadIdx.x] = 0u;
            for (int rep = 0; rep < (((REPMASK >> 0) & 1u) ? 2 : 1); ++rep) p0_prologue(a, lds);
            grid.sync();
            xbar = xcd_barrier_post(barw, bst);
        }
        ++ph;
    }
    bf16* XB = (bf16*)(ws + WS_XB); bf16* HZ = (bf16*)(ws + WS_HZ); bf16* MIX = (bf16*)(ws + WS_MIX); float* SSQ = (float*)(ws + WS_SSQ);
    for (int st = 0; st < 4; ++st) {
        const int l = st >> 1;
        PH_BEGIN(1) {
            pg8::Gemm g{XB, (const bf16*)(ws + WS_WGU + st * SZ_WGU), M, 2 * DFF, D}; pg8::StaticOrder S; S.init(M, 2 * DFF, G, bid);
            EpiSwiglu E{HZ, SSQ, lds};
            pg8::gemm_phase<EpiSwiglu, pg8::StaticOrder, true, true>(lds, g, S, E);
            if (st == 0) tail_convert(a, lds, 2 * CV_GU, CV_ST, 4 * CV_ST, 4 * CV_ST + CV_L, 0, S.nwg % G, G, bid);
            else if (st == 1) tail_convert(a, lds, 3 * CV_ST, 4 * CV_ST, 0, 0, -1, S.nwg % G, G, bid);
        } PH_END
        PH_BEGIN(2) {
            pg8::Gemm g{HZ, (const bf16*)(ws + WS_WD + st * SZ_WD), M, D, DFF}; DownOrder S; S.init(G, bid);
            EpiResid E{XB, dummy ? MIX : XB, dummy ? (float*)(ws + 963 * MiB) : SSQ, 0.5f, (float*)(ws + WS_US)};
            pg8::gemm_phase<EpiResid, DownOrder, true, true>(lds, g, S, E);
            if (st == 0) tail_convert(a, lds, CV_ST, 2 * CV_ST, 0, 0, -1, (S.so.nwg + 8 * KSPLIT) % G, G, bid);
        } PH_END
        PH_BEGIN(9) { down_reduce(a); } PH_END
        if ((st & 1) == 0) {
            PH_BEGIN(3) {
                pg8::Gemm g{XB, (const bf16*)(ws + WS_WIN + l * SZ_WIN), M, INW, D}; pg8::StaticOrder S; S.init(M, INW, G, bid);
                EpiScale E{HZ, SSQ, INW, lds};
                pg8::gemm_phase<EpiScale, pg8::StaticOrder, true, true>(lds, g, S, E);
                if (l == 0) tail_convert(a, lds, 2 * CV_ST, 3 * CV_ST, 0, 0, -1, S.nwg % G, G, bid);
            } PH_END
            PH_BEGIN(4) {
                for (int r2 = 0; r2 < (((REPMASK >> 9) & 1u) ? 2 : 1); ++r2) for (int u = bid; u < NCH; u += G) { if (u < NCH_P) m1_lru_unit<true>(a, lds, l, u); else m1_lru_unit<false>(a, lds, l, u); }
                for (int r2 = 0; r2 < (((REPMASK >> 10) & 1u) ? 2 : 1); ++r2) { int tid_ = threadIdx.x; asm volatile("" : "+v"(tid_)); const int tid = tid_;
                    int u = bid; while (u < NCH) u += G;     HgPre nx{}; if (u < NCH * 5) hg_load<false>(nx, a, (u - NCH) >> 2, (u - NCH) & 3, tid);
                    for (; u < NCH * 5; u += G) { const HgPre cur = nx; const int un = u + G; if (un < NCH * 5) hg_load<false>(nx, a, (un - NCH) >> 2, (un - NCH) & 3, tid);
                        if (((u - NCH) >> 2) < NCH_P) m1_hgrn_unit<true>(cur, a, lds, l, (u - NCH) >> 2, (u - NCH) & 3, tid); else m1_hgrn_unit<false>(cur, a, lds, l, (u - NCH) >> 2, (u - NCH) & 3, tid); } }
            } PH_END
            PH_BEGIN(5) { m2_scan(a, l); } PH_END
            PH_BEGIN(6) {
                for (int r2 = 0; r2 < (((REPMASK >> 11) & 1u) ? 2 : 1); ++r2) for (int u = bid; u < NCH; u += G) { if (u < NCH_P) m3_elem_unit<true>(a, lds, l, u); else m3_elem_unit<false>(a, lds, l, u); }
                for (int r2 = 0; r2 < (((REPMASK >> 12) & 1u) ? 2 : 1); ++r2) { int tid_ = threadIdx.x; asm volatile("" : "+v"(tid_)); const int tid = tid_;
                    int u = bid; while (u < NCH) u += G;     HgPre nx{}; if (u < NCH * 5) hg_load<true>(nx, a, (u - NCH) >> 2, (u - NCH) & 3, tid);
                    for (; u < NCH * 5; u += G) { const HgPre cur = nx; const int un = u + G; if (un < NCH * 5) hg_load<true>(nx, a, (un - NCH) >> 2, (un - NCH) & 3, tid);
                        if (((u - NCH) >> 2) < NCH_P) m3_hgrn_unit<true>(cur, a, lds, l, (u - NCH) >> 2, (u - NCH) & 3, tid); else m3_hgrn_unit<false>(cur, a, lds, l, (u - NCH) >> 2, (u - NCH) & 3, tid); } }
            } PH_END
            PH_BEGIN(7) {
                pg8::Gemm g{MIX, (const bf16*)(ws + WS_WOUT + l * SZ_WOUT), M, D, D}; pg8::StaticOrder S; S.init(M, D, G, bid);
                EpiResid E{XB, dummy ? HZ : XB, dummy ? (float*)(ws + 963 * MiB) : SSQ, 1.0f, nullptr};
                pg8::gemm_phase<EpiResid, pg8::StaticOrder, true, true>(lds, g, S, E);
                if (l == 0) tail_convert(a, lds, 4 * CV_ST + CV_L, 4 * CV_ST + 2 * CV_L, 0, 0, 1, S.nwg % G, G, bid);
            } PH_END
        }
    }
    PH_BEGIN(8) pf_final(a); PH_END
}

#ifndef MK_PER_PHASE
#define MK_PER_PHASE 0
#endif
constexpr int N_PHASES = 1 + 4 * 3 + 2 * 5 + 1;
extern "C" void kernel_launch(void* const* d_in, const int* in_sizes, int n_in, void* d_out, int out_size, void* d_ws, size_t ws_size, hipStream_t stream) {
    static int grid = 0;
    if (grid == 0) {
        if (n_in != 29 || (size_t)out_size != O_END || ws_size < WS_END + (REPMASK ? 8 * MiB : 0)) { fprintf(stderr, "kernel_launch: unexpected shapes: n_in %d out %d ws %zu (need %zu)\n", n_in, out_size, ws_size, (size_t)WS_END); grid = -1; return; }
        int dev = 0, cus = 0, per_cu = 0;
        if (hipGetDevice(&dev) != hipSuccess || hipDeviceGetAttribute(&cus, hipDeviceAttributeMultiprocessorCount, dev) != hipSuccess) { grid = -1; return; }
        if (hipFuncSetAttribute((const void*)fwd_kernel, hipFuncAttributeMaxDynamicSharedMemorySize, LDS_BYTES) != hipSuccess) { fprintf(stderr, "kernel_launch: hipFuncSetAttribute failed\n"); grid = -1; return; }
        if (hipOccupancyMaxActiveBlocksPerMultiprocessor(&per_cu, (const void*)fwd_kernel, NT, LDS_BYTES) != hipSuccess || per_cu < 1) { fprintf(stderr, "kernel_launch: occupancy query says %d\n", per_cu); per_cu = 1; }
        (void)hipGetLastError();
        grid = cus * per_cu;
    }
    if (grid < 0) return;
    Args a{};
    for (int i = 0; i < 29; ++i) a.in[i] = (const float*)d_in[i];
    a.out = (float*)d_out; a.ws = (unsigned char*)d_ws;
#if MK_PER_PHASE
    for (int p = 0; p < N_PHASES; ++p) { a.ph_lo = p; a.ph_hi = p + 1; void* args[] = {&a};
        hipError_t e = hipLaunchCooperativeKernel((const void*)fwd_kernel, dim3(grid), dim3(NT), args, LDS_BYTES, stream);
        if (e != hipSuccess) { fprintf(stderr, "launch %d failed: %s\n", p, hipGetErrorString(e)); break; } }
#else
    a.ph_lo = 0; a.ph_hi = N_PHASES; void* args[] = {&a};
    hipError_t e = hipLaunchCooperativeKernel((const void*)fwd_kernel, dim3(grid), dim3(NT), args, LDS_BYTES, stream);
    if (e != hipSuccess) fprintf(stderr, "cooperative launch failed: %s (grid %d)\n", hipGetErrorString(e), grid);
#endif
}
```

```cpp
#include <hip/hip_runtime.h>
#include <hip/hip_cooperative_groups.h>
#include <cstdio>
#include <cstdint>
namespace cg = cooperative_groups;
namespace pg8 {
#define PG8_LAS __attribute__((address_space(3)))
typedef unsigned short bf16_t;
typedef short bf16x8 __attribute__((ext_vector_type(8)));
typedef float f32x4 __attribute__((ext_vector_type(4)));
typedef unsigned u32x4 __attribute__((ext_vector_type(4)));
constexpr int BM = 256, BK = 64, HALF = 128, HTB = HALF * BK * 2  , STAGE_BYTES = 8 * HTB, NXCD = 8, WGM = 8;

__host__ __device__ __forceinline__ int lds_byte(int r, int c) { const int st = (r >> 4) * 2 + (c >> 5), rr = r & 15, cc = c & 31, ob = rr * 64 + cc * 2; return st * 1024 + (ob ^ (((ob >> 9) & 1) << 5)); }
__host__ __device__ __forceinline__ void stage_rc(int b, int& R, int& C) { const int st = b / 1024, sb = b % 1024, swz = sb ^ (((sb >> 9) & 1) << 5); R = (st >> 1) * 16 + swz / 64; C = (st & 1) * 32 + (swz % 64) / 2; }
__host__ __device__ __forceinline__ int perm32(int rho) { const int n = rho >> 4, i = rho & 15; return 8 * (i >> 2) + 4 * n + (i & 3); }

constexpr int PART_NT = 4;
struct Unit { int pm, pn, kc; };
struct Gemm { const bf16_t* A; const bf16_t* Bt; int M, N, K; };

struct StaticOrder {
    int nM, nN, nwg, G, c;
    __host__ __device__ void init(int M, int N, int G_, int c_) { nM = M / BM; nN = N / BM; nwg = nM * nN; G = G_; c = c_; }
    __host__ __device__ void map(int L, int& pm, int& pn) const {
        int wgid = L; { const int q = nwg / NXCD, r = nwg % NXCD, xcd = wgid % NXCD, off = wgid / NXCD; wgid = (xcd < r ? xcd * (q + 1) : r * (q + 1) + (xcd - r) * q) + off; }
        const int nig = WGM * nN, gid = wgid / nig, fm = gid * WGM, gsz = (nM - fm) < WGM ? (nM - fm) : WGM;
        pm = fm + ((wgid % nig) % gsz); pn = (wgid % nig) / gsz;
    }
    __host__ __device__ bool next(int i, Unit& u) const {
        const long L = (long)i * G + c; if (L >= nwg) return false;
        int pm, pn; map((int)L, pm, pn); u.pm = pm; u.pn = pn; u.kc = -1; return true;
    }
    __device__ __forceinline__ void a_ready(const Unit&) const {}
    __device__ __forceinline__ void done(const Unit&) const {}
};

__device__ __forceinline__ unsigned cvt_pk_bf16(float lo, float hi) { unsigned r; asm volatile("v_cvt_pk_bf16_f32 %0, %1, %2" : "=v"(r) : "v"(lo), "v"(hi)); return r; }
template <class Epi, class Sched, bool ALIGN_EPI = false, bool SP2 = false>
__device__ __forceinline__ void gemm_phase(PG8_LAS unsigned char* lds, const Gemm g, const Sched& S, const Epi& E) {
    int tid_ = threadIdx.x; asm volatile("" : "+v"(tid_));
    const int tid = tid_, wid = __builtin_amdgcn_readfirstlane(tid >> 6), lane = tid & 63, wr = wid >> 2, wc = wid & 3, fr = lane & 15, fq = lane >> 4;
    const int K = g.K, nt = K / BK;
    unsigned voffA[2], voffB[2];
#pragma unroll
    for (int i = 0; i < 2; ++i) { int R, C; stage_rc(tid * 16 + i * 8192, R, C); const int Rb = Epi::PERM ? ((R & ~31) + perm32(R & 31)) : R;
        voffA[i] = (unsigned)(R * K + C) * 2u; voffB[i] = (unsigned)(Rb * K + C) * 2u; }
    const size_t kstep = (size_t)(BK * 2);
    const size_t hstep = (size_t)HALF * K * 2;
    const size_t tstep = 2 * hstep;
    const unsigned ldsw = (unsigned)wid * 1024u;
    const int aoff = lds_byte(wr * 64 + fr, fq * 8), boff = lds_byte(wc * 32 + fr, fq * 8);
#define PG8_SA(b, h) (((b) * 2 + (h)) * HTB)
#define PG8_SB(b, h) ((4 + (b) * 2 + (h)) * HTB)
#define PG8_STAGE(bufoff, gbase, voff) do { _Pragma("unroll") for (int _i = 0; _i < 2; ++_i) \
        __builtin_amdgcn_global_load_lds((const unsigned*)((const char*)(gbase) + (voff)[_i]), (PG8_LAS unsigned*)(lds + (bufoff) + ldsw + _i * 8192), 16, 0, 0); } while (0)
#define PG8_LDA(dst, b, h) do { _Pragma("unroll") for (int m = 0; m < 4; ++m) _Pragma("unroll") for (int k = 0; k < 2; ++k) dst[m][k] = *(const PG8_LAS bf16x8*)(lds + PG8_SA(b, h) + aoff + m * 2048 + k * 1024); } while (0)
#define PG8_LDB(dst, b, h) do { _Pragma("unroll") for (int n = 0; n < 2; ++n) _Pragma("unroll") for (int k = 0; k < 2; ++k) dst[n][k] = *(const PG8_LAS bf16x8*)(lds + PG8_SB(b, h) + boff + n * 2048 + k * 1024); } while (0)
#define PG8_MMA(ai, bj, At, Bt) do { __builtin_amdgcn_s_setprio(1); _Pragma("unroll") for (int m = 0; m < 4; ++m) _Pragma("unroll") for (int n = 0; n < 2; ++n) _Pragma("unroll") for (int k = 0; k < 2; ++k) \
        acc[ai][bj][m][n] = __builtin_amdgcn_mfma_f32_16x16x32_bf16(Bt[n][k], At[m][k], acc[ai][bj][m][n], 0, 0, 0); __builtin_amdgcn_s_setprio(0); } while (0)
#define PG8_WAIT_V(n) asm volatile("s_waitcnt vmcnt(" #n ")" ::: "memory")
#define PG8_WAIT_L(n) asm volatile("s_waitcnt lgkmcnt(" #n ")" ::: "memory")
#define PG8_BAR __builtin_amdgcn_s_barrier()
#define PG8_SCHED __builtin_amdgcn_sched_barrier(0)
    Unit cur, nxt; int ui = 0;
    if (!S.next(0, cur)) return;
    f32x4 acc[2][2][4][2];
#pragma unroll
    for (int a = 0; a < 2; ++a)
#pragma unroll
        for (int b = 0; b < 2; ++b)
#pragma unroll
            for (int m = 0; m < 4; ++m)
#pragma unroll
                for (int n = 0; n < 2; ++n) acc[a][b][m][n] = (f32x4){0.f, 0.f, 0.f, 0.f};
    bf16x8 At[4][2], B0[2][2], B1[2][2];
    const char* cA = (const char*)g.A + (size_t)cur.pm * tstep + (cur.kc >= 0 ? cur.kc * (PART_NT * BK * 2) : 0); const char* cB = (const char*)g.Bt + (size_t)cur.pn * tstep + (cur.kc >= 0 ? cur.kc * (PART_NT * BK * 2) : 0);
    S.a_ready(cur);
    if (wr == 1) E.stage(cur, lds, wid, lane);
    if constexpr (SP2) {
        PG8_STAGE(PG8_SB(0, 0), cB, voffB); PG8_STAGE(PG8_SB(0, 1), cB + hstep, voffB); PG8_STAGE(PG8_SA(0, 0), cA, voffA); PG8_STAGE(PG8_SA(0, 1), cA + hstep, voffA);
        if (wr == 1) PG8_BAR;
        PG8_WAIT_V(2); PG8_BAR;
        PG8_STAGE(PG8_SB(1, 0), cB + kstep, voffB); PG8_STAGE(PG8_SA(1, 0), cA + kstep, voffA); PG8_STAGE(PG8_SB(1, 1), cB + hstep + kstep, voffB);
        PG8_WAIT_V(6); PG8_BAR;
    } else {
        PG8_STAGE(PG8_SB(0, 0), cB, voffB); PG8_STAGE(PG8_SA(0, 0), cA, voffA); PG8_STAGE(PG8_SB(0, 1), cB + hstep, voffB); PG8_STAGE(PG8_SA(0, 1), cA + hstep, voffA);
        if (wr == 1) PG8_BAR;
        PG8_WAIT_V(4); PG8_BAR;
        PG8_STAGE(PG8_SB(1, 0), cB + kstep, voffB); PG8_STAGE(PG8_SA(1, 0), cA + kstep, voffA); PG8_STAGE(PG8_SB(1, 1), cB + hstep + kstep, voffB);
        PG8_WAIT_V(6); PG8_BAR;
    }
    for (;;) {
        const bool has_next = S.next(ui + 1, nxt);
        const char* nA = has_next ? (const char*)g.A + (size_t)nxt.pm * tstep + (nxt.kc >= 0 ? nxt.kc * (PART_NT * BK * 2) : 0) : cA; const char* nB = has_next ? (const char*)g.Bt + (size_t)nxt.pn * tstep + (nxt.kc >= 0 ? nxt.kc * (PART_NT * BK * 2) : 0) : cB;
        const int unt = __builtin_amdgcn_readfirstlane(cur.kc >= 0 ? PART_NT : nt);
        for (int t = 0; t < unt; t += 2) {
            const bool last = (t == unt - 2);
            const char* a1 = cA + (size_t)(t + 1) * kstep;
            const char* a2 = last ? nA : cA + (size_t)(t + 2) * kstep; const char* b2 = last ? nB : cB + (size_t)(t + 2) * kstep;
            const char* a3 = a2 + kstep; const char* b3 = b2 + kstep;
            if (last && has_next) S.a_ready(nxt);
            if constexpr (SP2) {
            PG8_LDB(B0, 0, 0); PG8_LDB(B1, 0, 1); PG8_SCHED; PG8_LDA(At, 0, 0); PG8_STAGE(PG8_SA(1, 1), a1 + hstep, voffA);
            PG8_WAIT_V(8); PG8_WAIT_L(0); PG8_BAR; PG8_MMA(0, 0, At, B0); PG8_MMA(0, 1, At, B1); PG8_BAR; PG8_SCHED;
            PG8_LDA(At, 0, 1); PG8_STAGE(PG8_SB(0, 0), b2, voffB); PG8_STAGE(PG8_SB(0, 1), b2 + hstep, voffB); PG8_STAGE(PG8_SA(0, 0), a2, voffA);
            PG8_WAIT_V(8); PG8_WAIT_L(0); PG8_BAR; PG8_MMA(1, 0, At, B0); PG8_MMA(1, 1, At, B1); PG8_BAR; PG8_SCHED;
            PG8_LDB(B0, 1, 0); PG8_LDB(B1, 1, 1); PG8_SCHED; PG8_LDA(At, 1, 0); PG8_STAGE(PG8_SA(0, 1), a2 + hstep, voffA);
            PG8_WAIT_V(8); PG8_WAIT_L(0); PG8_BAR; PG8_MMA(0, 0, At, B0); PG8_MMA(0, 1, At, B1); PG8_BAR; PG8_SCHED;
            PG8_LDA(At, 1, 1); PG8_STAGE(PG8_SB(1, 0), b3, voffB); PG8_STAGE(PG8_SB(1, 1), b3 + hstep, voffB); PG8_STAGE(PG8_SA(1, 0), a3, voffA);
            PG8_WAIT_V(8); PG8_WAIT_L(0); PG8_BAR; PG8_MMA(1, 0, At, B0); PG8_MMA(1, 1, At, B1); PG8_BAR; PG8_SCHED;
            } else {
            PG8_LDB(B0, 0, 0); PG8_SCHED; PG8_LDA(At, 0, 0); PG8_STAGE(PG8_SA(1, 1), a1 + hstep, voffA);
            PG8_WAIT_L(8); PG8_BAR; PG8_WAIT_L(0); PG8_MMA(0, 0, At, B0); PG8_BAR; PG8_SCHED;
            PG8_LDB(B1, 0, 1); PG8_STAGE(PG8_SB(0, 0), b2, voffB);
            PG8_BAR; PG8_WAIT_L(0); PG8_MMA(0, 1, At, B1); PG8_BAR;
            PG8_LDA(At, 0, 1); PG8_STAGE(PG8_SA(0, 0), a2, voffA);
            PG8_BAR; PG8_WAIT_L(0); PG8_MMA(1, 0, At, B0); PG8_BAR; PG8_SCHED;
            PG8_STAGE(PG8_SB(0, 1), b2 + hstep, voffB);
            PG8_WAIT_V(6); PG8_BAR; PG8_MMA(1, 1, At, B1); PG8_BAR;
            PG8_LDB(B0, 1, 0); PG8_SCHED; PG8_LDA(At, 1, 0); PG8_STAGE(PG8_SA(0, 1), a2 + hstep, voffA);
            PG8_WAIT_L(8); PG8_BAR; PG8_WAIT_L(0); PG8_MMA(0, 0, At, B0); PG8_BAR; PG8_SCHED;
            PG8_LDB(B1, 1, 1); PG8_STAGE(PG8_SB(1, 0), b3, voffB);
            PG8_BAR; PG8_WAIT_L(0); PG8_MMA(0, 1, At, B1); PG8_BAR;
            PG8_LDA(At, 1, 1); PG8_STAGE(PG8_SA(1, 0), a3, voffA);
            PG8_BAR; PG8_WAIT_L(0); PG8_MMA(1, 0, At, B0); PG8_BAR; PG8_SCHED;
            PG8_STAGE(PG8_SB(1, 1), b3 + hstep, voffB);
            PG8_WAIT_V(6); PG8_BAR; PG8_MMA(1, 1, At, B1); PG8_BAR;
            }
        }
        if constexpr (ALIGN_EPI) { if (wr == 0) PG8_BAR; }
        if constexpr (!Epi::AFTER_DRAIN) { E(acc, cur, wr, wc, fr, fq); S.done(cur); }
        if (!has_next) break;
#pragma unroll
        for (int a = 0; a < 2; ++a)
#pragma unroll
            for (int b = 0; b < 2; ++b)
#pragma unroll
                for (int m = 0; m < 4; ++m)
#pragma unroll
                    for (int n = 0; n < 2; ++n) acc[a][b][m][n] = (f32x4){0.f, 0.f, 0.f, 0.f};
        cur = nxt; cA = nA; cB = nB; ++ui;
        if constexpr (ALIGN_EPI) { if (wr == 1) { PG8_BAR; E.stage(cur, lds, wid, lane); } }
    }
    PG8_WAIT_V(0);
    if constexpr (!ALIGN_EPI) { if (wr == 0) PG8_BAR; }
    PG8_BAR;
    if constexpr (Epi::AFTER_DRAIN) { E.fused(acc, cur, wr, wc, fr, fq, lds, wid, lane); S.done(cur); }
#undef PG8_SA
#undef PG8_SB
#undef PG8_STAGE
#undef PG8_LDA
#undef PG8_LDB
#undef PG8_MMA
#undef PG8_WAIT_V
#undef PG8_WAIT_L
#undef PG8_BAR
#undef PG8_SCHED
}
}

#define LAS __attribute__((address_space(3)))
#define DI __device__ __forceinline__
typedef unsigned short bf16;
typedef float f32x4 __attribute__((ext_vector_type(4)));
typedef float f32x2 __attribute__((ext_vector_type(2)));
typedef short bf16x8 __attribute__((ext_vector_type(8)));
typedef unsigned u32x4 __attribute__((ext_vector_type(4)));
typedef unsigned u32x2 __attribute__((ext_vector_type(2)));

constexpr int NT = 512;
constexpr int D = 1024, DFF = 2816, INW = 2816;
constexpr int MP = 65536, MS = 512, M = MP + MS;
constexpr int NCH_P = 1024, NCH_S = 32, NCH = NCH_P + NCH_S;
constexpr float EPS = 1e-6f;
constexpr int ZC_POOL = 0, ZC_XB = 256, ZC_GB = 512, ZC_Q = 768, ZC_F = 1280, ZC_V = 1792, ZC_G = 2304;
constexpr size_t O_YP = 0, O_YS = (size_t)MP * D, O_POOLP = O_YS + (size_t)MS * D, O_CONVP = O_POOLP + 2 * 8 * 15 * 256, O_LRUP = O_CONVP + 2 * 8 * 3 * 256,
                 O_HGP = O_LRUP + 2 * 8 * 256, O_POOLS = O_HGP + (size_t)2 * 8 * 4 * 16384, O_CONVS = O_POOLS + 2 * 32 * 15 * 256, O_LRUS = O_CONVS + 2 * 32 * 3 * 256,
                 O_HGS = O_LRUS + 2 * 32 * 256, O_END = O_HGS + (size_t)2 * 32 * 4 * 16384;
constexpr size_t MiB = 1u << 20;
constexpr size_t SZ_WGU = (size_t)5632 * 1024 * 2, SZ_WD = (size_t)1024 * 2816 * 2, SZ_WIN = (size_t)2816 * 1024 * 2, SZ_WOUT = (size_t)1024 * 1024 * 2;
constexpr size_t WS_BAR = 262144;
constexpr size_t WS_WG = 65536;
constexpr size_t WS_WGU = 1 * MiB, WS_WD = 45 * MiB, WS_WIN = 67 * MiB, WS_WOUT = 78 * MiB, WS_SSQ = 82 * MiB, WS_LB = 0, WS_DEC = 87 * MiB, WS_CARRY = 90 * MiB,
                 WS_XB = 92 * MiB, WS_HZ = 221 * MiB, WS_MIX = 576 * MiB, WS_US = 705 * MiB, WS_HL = 837 * MiB, WS_PP = 902 * MiB, WS_END = 967 * MiB;
static_assert(WS_WGU + 4 * SZ_WGU <= WS_WD && WS_WD + 4 * SZ_WD <= WS_WIN && WS_WIN + 2 * SZ_WIN <= WS_WOUT && WS_WOUT + 2 * SZ_WOUT <= WS_SSQ, "ws map 1");
static_assert(WS_SSQ + (size_t)M * 16 * 4 <= WS_DEC && WS_DEC + (size_t)NCH * 512 * 4 <= WS_CARRY && WS_CARRY + (size_t)NCH * 256 * 4 <= WS_XB, "ws map 2");
static_assert(WS_XB + (size_t)M * D * 2 <= WS_HZ && WS_HZ + (size_t)M * INW * 2 <= WS_MIX && WS_MIX + (size_t)M * D * 2 <= WS_US && WS_US + (size_t)NCH * 4 * 16384 * 2 <= WS_HL, "ws map 3");
static_assert(WS_HL + (size_t)M * 256 * 4 <= WS_PP && WS_PP + (size_t)M * 256 * 4 <= WS_END, "ws map 4");
constexpr int LDS_BYTES = 147456 + 2048;

struct Args { const float* in[29]; float* out; unsigned char* ws; int ph_lo, ph_hi; };

DI float bf2f(bf16 v) { return __uint_as_float((unsigned)v << 16); }
typedef __bf16 hwbf16x2 __attribute__((ext_vector_type(2)));
DI unsigned pk2(float lo, float hi) { const f32x2 v = {lo, hi}; const hwbf16x2 b = __builtin_convertvector(v, hwbf16x2); return __builtin_bit_cast(unsigned, b); }
DI unsigned f2bf(float f) { return pk2(f, 0.f) & 0xffffu; }
DI float frcp(float x) { return __builtin_amdgcn_rcpf(x); }
DI float fexp(float x) { return __builtin_amdgcn_exp2f(x * 1.4426950408889634f); }
DI float sigm(float x) { return frcp(1.f + fexp(-x)); }
DI float siluf(float x) { return x * frcp(1.f + fexp(-x)); }
DI float gelu_tanh(float x) { const float u = 0.7978845608028654f * (x + 0.044715f * x * x * x); return x * frcp(1.f + fexp(-2.f * u)); }
DI float clampf(float x, float lo, float hi) { return fminf(fmaxf(x, lo), hi); }
DI float wave_sum(float v) {
#pragma unroll
    for (int o = 1; o < 64; o <<= 1) v += __shfl_xor(v, o);
    return v;
}
DI int opaque_i(int v) { v = __builtin_amdgcn_readfirstlane(v); asm volatile("" : "+s"(v)); return v; }
DI int opaque_bid() { int b = blockIdx.x; asm volatile("" : "+s"(b)); return b; }
#define LDS_WAIT() asm volatile("s_waitcnt lgkmcnt(0)" ::: "memory")
#define BAR_LDS() do { asm volatile("s_waitcnt lgkmcnt(0)" ::: "memory"); __builtin_amdgcn_s_barrier(); asm volatile("" ::: "memory"); } while (0)
DI f32x4 mfma16(bf16x8 a, bf16x8 b, f32x4 c) { return __builtin_amdgcn_mfma_f32_16x16x32_bf16(a, b, c, 0, 0, 0); }

struct Chunk { int row0, nv, b, cis, smp; };
DI Chunk get_chunk(int ci) { Chunk c; if (ci < NCH_P) { c.b = ci >> 7; c.cis = ci & 127; c.row0 = ci * 64; c.nv = 64; c.smp = 0; } else { c.b = ci - NCH_P; c.cis = 0; c.row0 = MP + 16 * c.b; c.nv = 16; c.smp = 1; } return c; }

DI float row_rstd(const float* ssq, int row) {
    const f32x4* p = (const f32x4*)(ssq + (size_t)row * 16);
    const f32x4 a = p[0], b = p[1], c = p[2], d = p[3];
    const float s = ((a.x + a.y) + (a.z + a.w)) + ((b.x + b.y) + (b.z + b.w)) + ((c.x + c.y) + (c.z + c.w)) + ((d.x + d.y) + (d.z + d.w));
    return rsqrtf(s * (1.f / 1024.f) + EPS);
}
DI void rows_rstd(const float* ssq, int row0, int fq, float (&r)[2][4]) {
    f32x4 p[2][4];
#pragma unroll
    for (int ai = 0; ai < 2; ++ai)
#pragma unroll
        for (int m = 0; m < 4; ++m) p[ai][m] = *(const f32x4*)(ssq + (size_t)(row0 + ai * 128 + m * 16) * 16 + fq * 4);
#pragma unroll
    for (int ai = 0; ai < 2; ++ai)
#pragma unroll
        for (int m = 0; m < 4; ++m) { float s = (p[ai][m][0] + p[ai][m][1]) + (p[ai][m][2] + p[ai][m][3]); s += __shfl_xor(s, 16); s += __shfl_xor(s, 32); r[ai][m] = rsqrtf(s * (1.f / 1024.f) + EPS); }
}
constexpr int L_SSQT = 131072;
DI void stage_ssq_tile(const float* ssq, int pm, LAS unsigned char* lds, int wid, int lane) {
#pragma unroll
    for (int j = 0; j < 4; ++j)
        __builtin_amdgcn_global_load_lds((const unsigned*)(ssq + (size_t)pm * 4096 + ((wid - 4) * 4 + j) * 256 + lane * 4), (LAS unsigned*)(lds + L_SSQT + ((wid - 4) * 4 + j) * 1024), 16, 0, 0);
}
constexpr int L_RSTD = L_SSQT + 16384;
DI void rows_rstd_coop(LAS unsigned char* lds, int wr, int wc, int fr, int fq, float (&r)[2][4]) {
    const int tid = (wr * 4 + wc) * 64 + fq * 16 + fr, row = tid >> 1, hh = tid & 1;
    const f32x4 p0 = *(const LAS f32x4*)(lds + L_SSQT + row * 64 + hh * 32), p1 = *(const LAS f32x4*)(lds + L_SSQT + row * 64 + hh * 32 + 16);
    float s = ((p0[0] + p0[1]) + (p0[2] + p0[3])) + ((p1[0] + p1[1]) + (p1[2] + p1[3]));
    s += __shfl_xor(s, 1);
    if (hh == 0) *(LAS float*)(lds + L_RSTD + row * 4) = __builtin_amdgcn_rsqf(s * (1.f / 1024.f) + EPS);
    asm volatile("s_waitcnt lgkmcnt(0)" ::: "memory"); __builtin_amdgcn_s_barrier(); asm volatile("" ::: "memory");
#pragma unroll
    for (int ai = 0; ai < 2; ++ai)
#pragma unroll
        for (int m = 0; m < 4; ++m) r[ai][m] = *(const LAS float*)(lds + L_RSTD + (wr * 64 + fr + ai * 128 + m * 16) * 4);
}
struct EpiSwiglu {
    static constexpr bool PERM = true, AFTER_DRAIN = false;
    bf16* H; const float* ssq; LAS unsigned char* lds;
    DI void stage(const pg8::Unit& u, LAS unsigned char* l, int wid, int lane) const { stage_ssq_tile(ssq, u.pm, l, wid, lane); }
    DI void operator()(const f32x4 (&acc)[2][2][4][2], const pg8::Unit& u, int wr, int wc, int fr, int fq) const {
        const int row0 = u.pm * 256 + wr * 64 + fr, col = u.pn * 128 + wc * 32 + 8 * fq;
        float rr[2][4]; rows_rstd_coop(lds, wr, wc, fr, fq, rr);
#pragma unroll
        for (int ai = 0; ai < 2; ++ai)
#pragma unroll
            for (int m = 0; m < 4; ++m) {
                const int row = row0 + ai * 128 + m * 16; const float r = rr[ai][m];
                float h[8];
                const float rl = -1.4426950408889634f * r, r2 = r * r;
#pragma unroll
                for (int n = 0; n < 2; ++n)
#pragma unroll
                    for (int j = 0; j < 4; ++j) { const float g = acc[ai][0][m][n][j], up = acc[ai][1][m][n][j]; h[n * 4 + j] = (g * up) * r2 * frcp(1.f + __builtin_amdgcn_exp2f(g * rl)); }
                u32x4 w; w.x = pk2(h[0], h[1]); w.y = pk2(h[2], h[3]); w.z = pk2(h[4], h[5]); w.w = pk2(h[6], h[7]);
                *(u32x4*)(H + (size_t)row * DFF + col) = w;
            }
    }
};
struct EpiScale {
    static constexpr bool PERM = true, AFTER_DRAIN = false;
    bf16* Z; const float* ssq; int ldc; LAS unsigned char* lds;
    DI void stage(const pg8::Unit& u, LAS unsigned char* l, int wid, int lane) const { stage_ssq_tile(ssq, u.pm, l, wid, lane); }
    DI void operator()(const f32x4 (&acc)[2][2][4][2], const pg8::Unit& u, int wr, int wc, int fr, int fq) const {
        const int row0 = u.pm * 256 + wr * 64 + fr, col0 = u.pn * 256 + wc * 32 + 8 * fq;
        float rr[2][4]; rows_rstd_coop(lds, wr, wc, fr, fq, rr);
#pragma unroll
        for (int ai = 0; ai < 2; ++ai)
#pragma unroll
            for (int m = 0; m < 4; ++m) {
                const int row = row0 + ai * 128 + m * 16; const float r = rr[ai][m];
#pragma unroll
                for (int bj = 0; bj < 2; ++bj) {
                    const f32x4 v0 = acc[ai][bj][m][0] * r, v1 = acc[ai][bj][m][1] * r;
                    u32x4 w; w.x = pk2(v0[0], v0[1]); w.y = pk2(v0[2], v0[3]); w.z = pk2(v1[0], v1[1]); w.w = pk2(v1[2], v1[3]);
                    *(u32x4*)(Z + (size_t)row * ldc + col0 + bj * 128) = w;
                }
            }
    }
};
constexpr int KSPLIT = 11, KSPLIT_NT = pg8::PART_NT;
struct EpiResid {
    static constexpr bool PERM = true, AFTER_DRAIN = false;
    const bf16* XBin; bf16* XB; float* ssq; float alpha; float* part;
    DI void stage(const pg8::Unit&, LAS unsigned char*, int, int) const {}
    DI void operator()(const f32x4 (&acc)[2][2][4][2], const pg8::Unit& u, int wr, int wc, int fr, int fq) const {
        if (u.kc >= 0) {
            float* pt = part + ((size_t)(((u.pm - MP / 256) * 4 + u.pn) * KSPLIT + u.kc)) * 65536 + (size_t)(wr * 64 + fr) * 256 + wc * 32 + 8 * fq;
#pragma unroll
            for (int ai = 0; ai < 2; ++ai)
#pragma unroll
                for (int m = 0; m < 4; ++m)
#pragma unroll
                    for (int bj = 0; bj < 2; ++bj) { float* q = pt + (size_t)(ai * 128 + m * 16) * 256 + bj * 128; *(f32x4*)q = acc[ai][bj][m][0]; *(f32x4*)(q + 4) = acc[ai][bj][m][1]; }
            return;
        }
        const int row0 = u.pm * 256 + wr * 64 + fr, col0 = u.pn * 256 + wc * 32 + 8 * fq;
#pragma unroll
        for (int ai = 0; ai < 2; ++ai) {
            u32x4 bb[4][2];
#pragma unroll
            for (int m = 0; m < 4; ++m)
#pragma unroll
                for (int bj = 0; bj < 2; ++bj) bb[m][bj] = *(const u32x4*)(XBin + (size_t)(row0 + ai * 128 + m * 16) * D + col0 + bj * 128);
#pragma unroll
            for (int m = 0; m < 4; ++m) {
                const int row = row0 + ai * 128 + m * 16;
                float sq = 0.f;
#pragma unroll
                for (int bj = 0; bj < 2; ++bj) {
                    const int col = col0 + bj * 128;
                    const u32x4 b = bb[m][bj];
                    f32x4 v0, v1;
                    v0[0] = __uint_as_float(b.x << 16) + alpha * acc[ai][bj][m][0][0]; v0[1] = __uint_as_float(b.x & 0xffff0000u) + alpha * acc[ai][bj][m][0][1];
                    v0[2] = __uint_as_float(b.y << 16) + alpha * acc[ai][bj][m][0][2]; v0[3] = __uint_as_float(b.y & 0xffff0000u) + alpha * acc[ai][bj][m][0][3];
                    v1[0] = __uint_as_float(b.z << 16) + alpha * acc[ai][bj][m][1][0]; v1[1] = __uint_as_float(b.z & 0xffff0000u) + alpha * acc[ai][bj][m][1][1];
                    v1[2] = __uint_as_float(b.w << 16) + alpha * acc[ai][bj][m][1][2]; v1[3] = __uint_as_float(b.w & 0xffff0000u) + alpha * acc[ai][bj][m][1][3];
                    u32x4 w; w.x = pk2(v0[0], v0[1]); w.y = pk2(v0[2], v0[3]); w.z = pk2(v1[0], v1[1]); w.w = pk2(v1[2], v1[3]);
                    *(u32x4*)(XB + (size_t)row * D + col) = w;
                    const float r0 = __uint_as_float(w.x << 16), r1 = __uint_as_float(w.x & 0xffff0000u), r2 = __uint_as_float(w.y << 16), r3 = __uint_as_float(w.y & 0xffff0000u),
                                r4 = __uint_as_float(w.z << 16), r5 = __uint_as_float(w.z & 0xffff0000u), r6 = __uint_as_float(w.w << 16), r7 = __uint_as_float(w.w & 0xffff0000u);
                    sq += (r0 * r0 + r1 * r1) + (r2 * r2 + r3 * r3) + (r4 * r4 + r5 * r5) + (r6 * r6 + r7 * r7);
                }
                sq += __shfl_xor(sq, 16); sq += __shfl_xor(sq, 32);
                if (fq == 0) ssq[(size_t)row * 16 + u.pn * 4 + wc] = sq;
            }
        }
    }
};

struct DownOrder {
    pg8::StaticOrder so;
    DI void init(int G, int c) { so.init(MP, D, G, c); }
    DI bool next(int i, pg8::Unit& u) const {
        const long L = (long)i * so.G + so.c;
        if (L >= so.nwg + 8 * KSPLIT) return false;
        const bool prompt = L < so.nwg;
        int pm, pn; so.map(prompt ? (int)L : 0, pm, pn);
        const int s = prompt ? 0 : (int)(L - so.nwg), t8 = s / KSPLIT;
        u.pm = prompt ? pm : MP / 256 + (t8 >> 2); u.pn = prompt ? pn : (t8 & 3); u.kc = prompt ? -1 : s - t8 * KSPLIT;
        return true;
    }
    DI void a_ready(const pg8::Unit&) const {}
    DI void done(const pg8::Unit&) const {}
};
DI void down_reduce(const Args& a) {
    int tid_ = threadIdx.x; asm volatile("" : "+v"(tid_));
    const int lane = tid_ & 63, gw = opaque_bid() * 8 + (tid_ >> 6), NGW = opaque_i(gridDim.x * 8);
    const float* part = (const float*)(a.ws + WS_US); bf16* XB = (bf16*)(a.ws + WS_XB); float* SSQ = (float*)(a.ws + WS_SSQ);
    for (int it = gw; it < MS * 4; it += NGW) {
        const int r = it >> 2, pn = it & 3;
        const float* pt = part + ((size_t)(((r >> 8) * 4 + pn) * KSPLIT)) * 65536 + (size_t)(r & 255) * 256 + lane * 4;
        f32x4 sm = (f32x4){0.f, 0.f, 0.f, 0.f};
#pragma unroll
        for (int kc = 0; kc < KSPLIT; ++kc) sm += *(const f32x4*)(pt + (size_t)kc * 65536);
        u32x2* xp = (u32x2*)(XB + (size_t)(MP + r) * D + pn * 256 + lane * 4); const u32x2 b = *xp;
        u32x2 o; o.x = pk2(__uint_as_float(b.x << 16) + 0.5f * sm[0], __uint_as_float(b.x & 0xffff0000u) + 0.5f * sm[1]); o.y = pk2(__uint_as_float(b.y << 16) + 0.5f * sm[2], __uint_as_float(b.y & 0xffff0000u) + 0.5f * sm[3]);
        *xp = o;
        const float r0 = __uint_as_float(o.x << 16), r1 = __uint_as_float(o.x & 0xffff0000u), r2 = __uint_as_float(o.y << 16), r3 = __uint_as_float(o.y & 0xffff0000u);
        const float sq = wave_sum((r0 * r0 + r1 * r1) + (r2 * r2 + r3 * r3));
        if (lane < 4) SSQ[(size_t)(MP + r) * 16 + pn * 4 + lane] = (lane == 0) ? sq : 0.f;
    }
}

DI void transpose_item(const float* W, int N, int Kdst, const float* gain, bf16* WT, int dst_row0, int kdst0, LAS float* scr, int k0, int n0, int lane) {
    {
        const int kr = lane >> 3, nc = (lane & 7) * 4; f32x4 w[8]; float g[8];
#pragma unroll
        for (int i = 0; i < 8; ++i) { const int kk = kr + 8 * i; w[i] = __builtin_nontemporal_load((const f32x4*)(W + (size_t)(k0 + kk) * N + n0 + nc)); g[i] = gain ? gain[k0 + kk] : 1.f; }
#pragma unroll
        for (int i = 0; i < 8; ++i) { const int kk = kr + 8 * i; LAS float* d = scr + kk * 33 + nc; d[0] = w[i][0] * g[i]; d[1] = w[i][1] * g[i]; d[2] = w[i][2] * g[i]; d[3] = w[i][3] * g[i]; }
    }
    LDS_WAIT(); asm volatile("" ::: "memory");
    const int c = lane & 7;
#pragma unroll
    for (int j = 0; j < 4; ++j) { const int n = (lane >> 3) + 8 * j; const LAS float* s = scr + (8 * c) * 33 + n;
        u32x4 o; o.x = pk2(s[0 * 33], s[1 * 33]); o.y = pk2(s[2 * 33], s[3 * 33]); o.z = pk2(s[4 * 33], s[5 * 33]); o.w = pk2(s[6 * 33], s[7 * 33]);
        *(u32x4*)(WT + (size_t)(dst_row0 + n) * Kdst + kdst0 + 8 * c) = o; }
    LDS_WAIT(); asm volatile("" ::: "memory");
}
DI void p0_prologue(const Args& a, LAS unsigned char* lds) {
    int tid_ = threadIdx.x; asm volatile("" : "+v"(tid_));
    const int tid = tid_, lane = tid & 63, wave = tid >> 6;
    const int obid = opaque_bid(); const int gw = obid * 8 + wave, NGW = opaque_i(gridDim.x * 8);
    unsigned char* ws = a.ws;
    LAS float* scr = (LAS float*)(lds + wave * 16384);
    constexpr int I_GU = 16 * 88, I_D = 44 * 32, I_IN = 16 * 88, I_OUT = 12 * 32;
    constexpr int PER_ST = 2 * I_GU + I_D, PER_L = I_IN + I_OUT, NITEMS = 4 * PER_ST + 2 * PER_L;
    for (int it = gw; it < NITEMS; it += NGW) {
        int r = it;
        if (r < 4 * PER_ST) {
            const int st = r / PER_ST; r -= st * PER_ST; const int l = st >> 1, f2 = st & 1;
            const float* gain = a.in[f2 ? 24 : 6] + l * D;
            if (r < 2 * I_GU) {
                const int up = r >= I_GU; if (up) r -= I_GU;
                const float* W = a.in[(f2 ? 25 : 7) + up] + (size_t)l * D * DFF;
                const int kb = r / 88, nb = r % 88, n0 = nb * 32;
                transpose_item(W, DFF, D, gain, (bf16*)(ws + WS_WGU + st * SZ_WGU), (n0 >> 7) * 256 + (n0 & 127) + up * 128, kb * 64, scr, kb * 64, n0, lane);
            } else {
                r -= 2 * I_GU;
                const float* W = a.in[f2 ? 27 : 9] + (size_t)l * DFF * D;
                const int kb = r / 32, nb = r % 32;
                transpose_item(W, D, DFF, nullptr, (bf16*)(ws + WS_WD + st * SZ_WD), nb * 32, kb * 64, scr, kb * 64, nb * 32, lane);
            }
        } else {
            r -= 4 * PER_ST; const int l = r / PER_L; r -= l * PER_L;
            if (r < I_IN) {
                const int kb = r / 88, nb = r % 88;
                transpose_item(a.in[11] + (size_t)l * D * INW, INW, D, a.in[10] + l * D, (bf16*)(ws + WS_WIN + l * SZ_WIN), nb * 32, kb * 64, scr, kb * 64, nb * 32, lane);
            } else {
                r -= I_IN; const int kb = 4 + r / 32, nb = r % 32;
                transpose_item(a.in[23] + (size_t)l * D * D, D, D, nullptr, (bf16*)(ws + WS_WOUT + l * SZ_WOUT), nb * 32, kb * 64, scr, kb * 64, nb * 32, lane);
            }
        }
    }
    const int gt = obid * NT + tid, NGT = opaque_i(gridDim.x * NT);
    for (int idx = gt; idx < 2 * 256 * 1024; idx += NGT) {
        const int n = idx & 1023, k = (idx >> 10) & 255, l = idx >> 18, g = k >> 6;
        const float* pw = a.in[12] + ((size_t)l * 256 + k) * 64; const float* sc = a.in[13] + l * 256 + g * 64; const float* wo = a.in[23] + (size_t)l * D * D + (size_t)(g * 64) * D + n;
        float s = 0.f;
#pragma unroll 8
        for (int d = 0; d < 64; ++d) s += pw[d] * sc[d] * wo[(size_t)d * D];
        ((bf16*)(ws + WS_WOUT + l * SZ_WOUT))[(size_t)n * D + k] = (bf16)f2bf(s);
    }
    for (int idx = gt; idx < 2 * 2 * 4 * 4096; idx += NGT) {
        const int c = idx & 63, d = (idx >> 6) & 63, g = (idx >> 12) & 3, gate = (idx >> 14) & 1, l = idx >> 15;
        ((bf16*)(ws + WS_WG))[idx] = (bf16)f2bf(a.in[gate ? 18 : 16][((size_t)(l * 4 + g) * 64 + c) * 64 + d]);
    }
    for (int k = gt; k < 512; k += NGT) {
        const float l0 = a.in[21][k], l1 = a.in[21][512 + k], mx = fmaxf(l0, l1), e0 = fexp(l0 - mx), e1 = fexp(l1 - mx), p0 = e0 / (e0 + e1), p1 = e1 / (e0 + e1);
        float* LB = (float*)(ws + WS_LB); LB[k] = fmaxf(p0 - p0, 0.f); LB[512 + k] = fmaxf((p0 + p1) - p0, 0.f);
    }
    bf16* XB = (bf16*)(ws + WS_XB); float* SSQ = (float*)(ws + WS_SSQ);
    for (int m0 = gw; m0 < M; m0 += 4 * NGW) {
        f32x4 v[4][4];
#pragma unroll
        for (int q = 0; q < 4; ++q) { const int m = (m0 + q * NGW < M) ? m0 + q * NGW : m0;
            const float* xr = (m < MP) ? a.in[0] + (size_t)m * D : a.in[1] + (size_t)(m - MP) * D;
#pragma unroll
            for (int j = 0; j < 4; ++j) v[q][j] = __builtin_nontemporal_load((const f32x4*)xr + 64 * j + lane); }
#pragma unroll
        for (int q = 0; q < 4; ++q) { const int m = m0 + q * NGW;
            if (m < M) { float s = 0.f;
#pragma unroll
                for (int j = 0; j < 4; ++j) { u32x2 o; o.x = pk2(v[q][j].x, v[q][j].y); o.y = pk2(v[q][j].z, v[q][j].w); ((u32x2*)(XB + (size_t)m * D))[64 * j + lane] = o;
                    const float r0 = __uint_as_float(o.x << 16), r1 = __uint_as_float(o.x & 0xffff0000u), r2 = __uint_as_float(o.y << 16), r3 = __uint_as_float(o.y & 0xffff0000u);
                    s += (r0 * r0 + r1 * r1) + (r2 * r2 + r3 * r3); }
                s = wave_sum(s);
                if (lane < 16) SSQ[(size_t)m * 16 + lane] = (lane == 0) ? s : 0.f; } }
    }
}

constexpr int L_QT = 0, L_KT = 17408, L_QH = 34816, L_VT = 52224, L_ATT = 70656, L_SEG = 79872, L_RED = 83968;
constexpr int L_CONV = 0, L_XC = 65536, L_ZX = 65536 + 33792;
constexpr int L_ZP = 0;

struct HgPre { unsigned fz[8]; unsigned q[8]; u32x4 v0, v1; };
template <bool M3> DI void hg_load(HgPre& p, const Args& a, int ci, int h, int tid) {
    const Chunk ch = get_chunk(ci); const bf16* Z = (const bf16*)(a.ws + WS_HZ);
    const bf16* zp = Z + (size_t)(ch.row0 + 8 * (tid >> 6)) * INW + h * 128 + 2 * (tid & 63);
#pragma unroll
    for (int i = 0; i < 8; ++i) p.fz[i] = *(const unsigned*)(zp + ZC_F + i * INW);
    if (M3) {
#pragma unroll
        for (int i = 0; i < 8; ++i) p.q[i] = *(const unsigned*)(zp + ZC_Q + i * INW);
    }
    { const u32x4* pv = (const u32x4*)(Z + (size_t)(ch.row0 + (tid & 63)) * INW + ZC_V + h * 128 + (tid >> 6) * 16); p.v0 = pv[0]; p.v1 = pv[1]; }
}
#define HG_LOAD_F()                                                                                                   \
    const int kp = tid & 63, sg = tid >> 6;
#define HG_CUMSUM()                                                                                                   \
    const f32x2 lb2 = *(const f32x2*)(LB + l * 512 + h * 128 + 2 * kp); const float oml0 = 1.f - lb2[0], oml1 = 1.f - lb2[1];   \
    float bc0[8], bc1[8], kk0[8], kk1[8];                                                                             \
    { float run0 = 0.f, run1 = 0.f;                                                                                   \
      _Pragma("unroll") for (int i = 0; i < 8; ++i) { const bool ok = FULL || (8 * sg + i) < ch.nv;                  \
          const float s0 = sigm(__uint_as_float(p.fz[i] << 16)), s1 = sigm(__uint_as_float(p.fz[i] & 0xffff0000u));  \
          const float lf0 = __logf(fmaxf(lb2[0] + oml0 * s0, 1e-30f)), lf1 = __logf(fmaxf(lb2[1] + oml1 * s1, 1e-30f)); \
          run0 += ok ? lf0 : 0.f; run1 += ok ? lf1 : 0.f; bc0[i] = run0; bc1[i] = run1;                               \
          kk0[i] = ok ? oml0 * (1.f - s0) : 0.f; kk1[i] = ok ? oml1 * (1.f - s1) : 0.f; }                             \
      *(LAS f32x2*)(SEG + sg * 128 + 2 * kp) = (f32x2){run0, run1}; }                                                 \
    BAR_LDS();                                                                                                        \
    float boff0 = 0.f, boff1 = 0.f, bref0 = 0.f, bref1 = 0.f, blast0 = 0.f, blast1 = 0.f;                             \
    _Pragma("unroll") for (int s_ = 0; s_ < 8; ++s_) { const f32x2 sv = *(const LAS f32x2*)(SEG + s_ * 128 + 2 * kp); \
        if (s_ < sg) { boff0 += sv[0]; boff1 += sv[1]; } if (s_ < 4) { bref0 += sv[0]; bref1 += sv[1]; } blast0 += sv[0]; blast1 += sv[1]; }   \
    _Pragma("unroll") for (int i = 0; i < 8; ++i) { bc0[i] += boff0; bc1[i] += boff1; }

#define HG_STORE_VT()                                                                                                 \
    { const int s = tid & 63, vb = tid >> 6; const bool ok = FULL || s < ch.nv;                                       \
      const u32x4 w0 = ok ? p.v0 : (u32x4){0u, 0u, 0u, 0u}, w1 = ok ? p.v1 : (u32x4){0u, 0u, 0u, 0u};                 \
      LAS bf16* vt = VT + (vb * 16) * 72 + s;                                                                         \
      _Pragma("unroll") for (int i = 0; i < 4; ++i) { vt[(2 * i) * 72] = (bf16)(w0[i] & 0xffffu); vt[(2 * i + 1) * 72] = (bf16)(w0[i] >> 16);   \
          vt[(8 + 2 * i) * 72] = (bf16)(w1[i] & 0xffffu); vt[(8 + 2 * i + 1) * 72] = (bf16)(w1[i] >> 16); } }

template <bool FULL> DI void m1_lru_unit(const Args& a, LAS unsigned char* lds, int l, int ci) {
    int tid_ = threadIdx.x; asm volatile("" : "+v"(tid_));
    const int tid = tid_, lane = tid & 63, wave = tid >> 6;
    const Chunk ch = get_chunk(ci);
    const bf16* Z = (const bf16*)(a.ws + WS_HZ);
    LAS float* CONV = (LAS float*)(lds + L_CONV); LAS bf16* XC = (LAS bf16*)(lds + L_XC);
    {
        LAS bf16* ZX = (LAS bf16*)(lds + L_ZX);
        const bool hist_z = (!ch.smp && ch.cis > 0);
        {
            u32x4 v[5];
#pragma unroll
            for (int it = 0; it < 5; ++it) { const int idx = tid + it * NT, rr = idx >> 5, pc = idx & 31, tp = rr - 3;
                const bool use_z = (idx < ((FULL ? 64 : ch.nv) + 3) * 32) && (tp >= 0 || hist_z);
                v[it] = *(const u32x4*)(Z + (size_t)(ch.row0 + (use_z ? tp : 0)) * INW + ZC_XB + pc * 8);
                if (!use_z) v[it] = (u32x4){0u, 0u, 0u, 0u}; }
#pragma unroll
            for (int it = 0; it < 5; ++it) { const int idx = tid + it * NT, rr = idx >> 5, pc = idx & 31, tp = rr - 3;
                if (idx < ((FULL ? 64 : ch.nv) + 3) * 32) {
                    u32x4 x = v[it];
                    if (!FULL && ch.smp && tp < 0) { const f32x4* p = (const f32x4*)(a.in[3] + ((size_t)(l * 32 + ch.b) * 3 + (3 + tp)) * 256 + pc * 8); const f32x4 p0 = p[0], p1 = p[1];
                        x.x = pk2(p0[0], p0[1]); x.y = pk2(p0[2], p0[3]); x.z = pk2(p1[0], p1[1]); x.w = pk2(p1[2], p1[3]); }
                    *(LAS u32x4*)(ZX + rr * 256 + pc * 8) = x; } }
        }
        const int c4 = (tid & 63) * 4, tq = tid >> 6;
        const f32x4 w0 = *(const f32x4*)(a.in[14] + (l * 4 + 0) * 256 + c4), w1 = *(const f32x4*)(a.in[14] + (l * 4 + 1) * 256 + c4), w2 = *(const f32x4*)(a.in[14] + (l * 4 + 2) * 256 + c4),
                    w3 = *(const f32x4*)(a.in[14] + (l * 4 + 3) * 256 + c4), cb = *(const f32x4*)(a.in[15] + l * 256 + c4);
        BAR_LDS();
#pragma unroll
        for (int i = 0; i < 8; ++i) { const int t = tq + 8 * i;
            if (FULL || t < ch.nv) {
                f32x4 cv = cb;
#pragma unroll
                for (int k = 0; k < 4; ++k) { const u32x2 x = *(const LAS u32x2*)(ZX + (t + k) * 256 + c4); const f32x4 wk = (k == 0) ? w0 : (k == 1) ? w1 : (k == 2) ? w2 : w3;
                    cv[0] += wk[0] * __uint_as_float(x.x << 16); cv[1] += wk[1] * __uint_as_float(x.x & 0xffff0000u); cv[2] += wk[2] * __uint_as_float(x.y << 16); cv[3] += wk[3] * __uint_as_float(x.y & 0xffff0000u); }
                *(LAS f32x4*)(CONV + t * 256 + c4) = cv; u32x2 o; o.x = pk2(cv[0], cv[1]); o.y = pk2(cv[2], cv[3]); *(LAS u32x2*)(XC + t * 264 + c4) = o;
            } }
    }
    const int g = wave & 3, dh = wave >> 2, quad = lane >> 4, l15 = lane & 15;
    bf16x8 Ba[2][2], Bx[2][2];
    {
        const bf16* wg = (const bf16*)(a.ws + WS_WG) + (size_t)((l * 2) * 4 + g) * 4096 + (dh * 32 + l15) * 64 + quad * 8;
#pragma unroll
        for (int nt = 0; nt < 2; ++nt)
#pragma unroll
            for (int ks = 0; ks < 2; ++ks) { Ba[nt][ks] = *(const bf16x8*)(wg + nt * 1024 + ks * 32); Bx[nt][ks] = *(const bf16x8*)(wg + 4 * 4096 + nt * 1024 + ks * 32); }
    }
    BAR_LDS();
    f32x4 accA[4][2], accX[4][2];
#pragma unroll
    for (int mt = 0; mt < 4; ++mt)
#pragma unroll
        for (int nt = 0; nt < 2; ++nt) { accA[mt][nt] = (f32x4){0.f, 0.f, 0.f, 0.f}; accX[mt][nt] = (f32x4){0.f, 0.f, 0.f, 0.f}; }
#pragma unroll
    for (int mt = 0; mt < 4; ++mt)
#pragma unroll
        for (int ks = 0; ks < 2; ++ks) {
            const bf16x8 af = *(const LAS bf16x8*)(XC + (mt * 16 + l15) * 264 + g * 64 + ks * 32 + quad * 8);
#pragma unroll
            for (int nt = 0; nt < 2; ++nt) { accA[mt][nt] = mfma16(af, Ba[nt][ks], accA[mt][nt]); accX[mt][nt] = mfma16(af, Bx[nt][ks], accX[mt][nt]); }
        }
    float* HL = (float*)(a.ws + WS_HL); float* PP = (float*)(a.ws + WS_PP);
#pragma unroll
    for (int nt = 0; nt < 2; ++nt) {
        const int c = g * 64 + dh * 32 + nt * 16 + l15;
        const float ba = a.in[17][l * 256 + c], bx = a.in[19][l * 256 + c], lam = a.in[20][l * 256 + c];
        const float spc = -8.f * log1pf(fexp(-lam));
        float carryH = 0.f, carryP = 1.f;
#pragma unroll
        for (int mt = 0; mt < 4; ++mt) {
            float hl[4], pl[4]; float hh = 0.f, pp = 1.f;
#pragma unroll
            for (int j = 0; j < 4; ++j) {
                const int t = mt * 16 + quad * 4 + j;
                float av = 1.f, bt = 0.f;
                if (FULL || t < ch.nv) {
                    const float r = sigm(accA[mt][nt][j] + ba), ig = sigm(accX[mt][nt][j] + bx);
                    const float la = spc * r; av = fexp(la);
                    float mult = __builtin_amdgcn_sqrtf(fmaxf(1.f - av * av, 0.f));
                    if (!ch.smp && ch.cis == 0 && t == 0) mult = 1.f;
                    bt = mult * (ig * CONV[t * 256 + c]);
                }
                hh = av * hh + bt; pp = pp * av; hl[j] = hh; pl[j] = pp;
            }
            float sa[4], sb[4];
#pragma unroll
            for (int q = 0; q < 4; ++q) { sa[q] = __shfl(pp, l15 + 16 * q); sb[q] = __shfl(hh, l15 + 16 * q); }
            float H0 = carryH, P0 = carryP;
#pragma unroll
            for (int q = 0; q < 3; ++q) if (q < quad) { H0 = sa[q] * H0 + sb[q]; P0 = P0 * sa[q]; }
#pragma unroll
            for (int j = 0; j < 4; ++j) { const int t = mt * 16 + quad * 4 + j;
                if (FULL || t < ch.nv) { const size_t o = (size_t)(ch.row0 + t) * 256 + c; HL[o] = hl[j] + pl[j] * H0; PP[o] = pl[j] * P0; } }
#pragma unroll
            for (int q = 0; q < 4; ++q) { carryH = sa[q] * carryH + sb[q]; carryP = carryP * sa[q]; }
        }
    }
    BAR_LDS();
}

template <bool FULL> DI void m1_hgrn_unit(const HgPre& p, const Args& a, LAS unsigned char* lds, int l, int ci, int h, int tid) {
    const int lane = tid & 63, wave = tid >> 6;
    const Chunk ch = get_chunk(ci);
    const bf16* Z = (const bf16*)(a.ws + WS_HZ); const float* LB = (const float*)(a.ws + WS_LB);
    LAS bf16* KT = (LAS bf16*)(lds + L_KT); LAS bf16* VT = (LAS bf16*)(lds + L_VT); LAS float* SEG = (LAS float*)(lds + L_SEG);
    HG_LOAD_F();
    HG_CUMSUM();
    (void)bref0; (void)bref1;
    {
        u32x4 w0, w1;
#pragma unroll
        for (int i = 0; i < 4; ++i) { w0[i] = pk2(kk0[2 * i] * fexp(blast0 - bc0[2 * i]), kk0[2 * i + 1] * fexp(blast0 - bc0[2 * i + 1]));
                                      w1[i] = pk2(kk1[2 * i] * fexp(blast1 - bc1[2 * i]), kk1[2 * i + 1] * fexp(blast1 - bc1[2 * i + 1])); }
        *(LAS u32x4*)(KT + (2 * kp) * 72 + sg * 8) = w0; *(LAS u32x4*)(KT + (2 * kp + 1) * 72 + sg * 8) = w1;
        if (sg == 0) *(f32x2*)((float*)(a.ws + WS_DEC) + (size_t)(ci * 4 + h) * 128 + 2 * kp) = (f32x2){fexp(blast0), fexp(blast1)};
    }
    HG_STORE_VT();
    BAR_LDS();
    const int quad = lane >> 4, l15 = lane & 15;
    bf16x8 af[2];
#pragma unroll
    for (int ks = 0; ks < 2; ++ks) af[ks] = *(const LAS bf16x8*)(KT + (wave * 16 + l15) * 72 + ks * 32 + quad * 8);
    bf16* UT = (bf16*)(a.ws + WS_US) + (size_t)(ci * 4 + h) * 16384;
#pragma unroll
    for (int vt = 0; vt < 8; ++vt) {
        f32x4 acc = (f32x4){0.f, 0.f, 0.f, 0.f};
#pragma unroll
        for (int ks = 0; ks < 2; ++ks) { const bf16x8 bfr = *(const LAS bf16x8*)(VT + (vt * 16 + l15) * 72 + ks * 32 + quad * 8); acc = mfma16(af[ks], bfr, acc); }
        u32x2 o; o.x = pk2(acc[0], acc[1]); o.y = pk2(acc[2], acc[3]);
        *(u32x2*)(UT + (vt * 16 + l15) * 128 + wave * 16 + quad * 4) = o;
    }
    BAR_LDS();
}

DI void m2_scan(const Args& a, int l) {
    int tid_ = threadIdx.x; asm volatile("" : "+v"(tid_));
    const int gt = opaque_bid() * NT + tid_, NGT = opaque_i(gridDim.x * NT);
    bf16* US = (bf16*)(a.ws + WS_US); const float* DEC = (const float*)(a.ws + WS_DEC);
    const bf16* Z = (const bf16*)(a.ws + WS_HZ);
    for (int it = gt; it < 32 * 4096; it += NGT) {
        const int bh = it >> 12, e = (it & 4095) * 4, b = bh >> 2, h = bh & 3, k = e & 127, v = e >> 7;
        f32x4 S = (f32x4){0.f, 0.f, 0.f, 0.f};
        u32x2 un[8]; f32x4 dn[8];
#pragma unroll
        for (int j = 0; j < 8; ++j) { const size_t cu = (size_t)((b * 128 + j) * 4 + h); un[j] = *(const u32x2*)(US + cu * 16384 + e); dn[j] = *(const f32x4*)(DEC + cu * 128 + k); }
        for (int c0 = 0; c0 < 128; c0 += 8) {
            u32x2 u[8]; f32x4 d[8];
#pragma unroll
            for (int j = 0; j < 8; ++j) { u[j] = un[j]; d[j] = dn[j]; }
            if (c0 + 8 < 128) {
#pragma unroll
                for (int j = 0; j < 8; ++j) { const size_t cu = (size_t)((b * 128 + c0 + 8 + j) * 4 + h); un[j] = *(const u32x2*)(US + cu * 16384 + e); dn[j] = *(const f32x4*)(DEC + cu * 128 + k); }
            }
#pragma unroll
            for (int j = 0; j < 8; ++j) { const size_t cu = (size_t)((b * 128 + c0 + j) * 4 + h);
                u32x2 o; o.x = pk2(S[0], S[1]); o.y = pk2(S[2], S[3]); *(u32x2*)(US + cu * 16384 + e) = o;
                S[0] = d[j][0] * S[0] + __uint_as_float(u[j].x << 16); S[1] = d[j][1] * S[1] + __uint_as_float(u[j].x & 0xffff0000u);
                S[2] = d[j][2] * S[2] + __uint_as_float(u[j].y << 16); S[3] = d[j][3] * S[3] + __uint_as_float(u[j].y & 0xffff0000u); }
        }
        float* o = a.out + O_HGP + ((size_t)((l * 8 + b) * 4 + h)) * 16384 + v;
#pragma unroll
        for (int j = 0; j < 4; ++j) o[(size_t)(k + j) * 128] = S[j];
    }
    for (int it = gt; it < 128 * 4096; it += NGT) {
        const int bh = it >> 12, e = (it & 4095) * 4, b = bh >> 2, h = bh & 3, k = e & 127, v = e >> 7;
        const float* s0 = a.in[5] + ((size_t)((l * 32 + b) * 4 + h)) * 16384 + v;
        const size_t cu = (size_t)((NCH_P + b) * 4 + h);
        const u32x2 u = *(const u32x2*)(US + cu * 16384 + e); const f32x4 d = *(const f32x4*)(DEC + cu * 128 + k);
        f32x4 S;
#pragma unroll
        for (int j = 0; j < 4; ++j) S[j] = s0[(size_t)(k + j) * 128];
        u32x2 ob; ob.x = pk2(S[0], S[1]); ob.y = pk2(S[2], S[3]); *(u32x2*)(US + cu * 16384 + e) = ob;
        S[0] = d[0] * S[0] + __uint_as_float(u.x << 16); S[1] = d[1] * S[1] + __uint_as_float(u.x & 0xffff0000u);
        S[2] = d[2] * S[2] + __uint_as_float(u.y << 16); S[3] = d[3] * S[3] + __uint_as_float(u.y & 0xffff0000u);
        float* o = a.out + O_HGS + ((size_t)((l * 32 + b) * 4 + h)) * 16384 + v;
#pragma unroll
        for (int j = 0; j < 4; ++j) o[(size_t)(k + j) * 128] = S[j];
    }
    const float* HL = (const float*)(a.ws + WS_HL); const float* PP = (const float*)(a.ws + WS_PP); float* CARRY = (float*)(a.ws + WS_CARRY);
    for (int it = NGT - 1 - gt; it < 2048 + 8192; it += NGT) {
        if (it < 2048) { const int b = it >> 8, c = it & 255; float hcar = 0.f;
            for (int c0 = 0; c0 < 128; c0 += 32) { float p[32], q[32];
#pragma unroll
                for (int j = 0; j < 32; ++j) { const size_t o = (size_t)(b * 8192 + (c0 + j) * 64 + 63) * 256 + c; p[j] = PP[o]; q[j] = HL[o]; }
#pragma unroll
                for (int j = 0; j < 32; ++j) { CARRY[(size_t)(b * 128 + c0 + j) * 256 + c] = hcar; hcar = p[j] * hcar + q[j]; } }
            a.out[O_LRUP + (size_t)(l * 8 + b) * 256 + c] = hcar;
        } else { const int i2 = it - 2048, b = i2 >> 8, c = i2 & 255; const float h0 = a.in[4][(size_t)(l * 32 + b) * 256 + c];
            const size_t o = (size_t)(MP + b * 16 + 15) * 256 + c; CARRY[(size_t)(NCH_P + b) * 256 + c] = h0; a.out[O_LRUS + (size_t)(l * 32 + b) * 256 + c] = PP[o] * h0 + HL[o]; }
    }
    for (int it = gt; it < 8 * 15 * 256; it += NGT) { const int c = it & 255, j = (it >> 8) % 15, b = it / (15 * 256); a.out[O_POOLP + (size_t)l * 8 * 15 * 256 + it] = bf2f(Z[(size_t)(b * 8192 + 8177 + j) * INW + ZC_POOL + c]); }
    for (int it = gt; it < 8 * 3 * 256; it += NGT) { const int c = it & 255, j = (it >> 8) % 3, b = it / (3 * 256); a.out[O_CONVP + (size_t)l * 8 * 3 * 256 + it] = bf2f(Z[(size_t)(b * 8192 + 8189 + j) * INW + ZC_XB + c]); }
    for (int it = gt; it < 32 * 15 * 256; it += NGT) { const int c = it & 255, j = (it >> 8) % 15, b = it / (15 * 256); a.out[O_POOLS + (size_t)l * 32 * 15 * 256 + it] = bf2f(Z[(size_t)(MP + b * 16 + 1 + j) * INW + ZC_POOL + c]); }
    for (int it = gt; it < 32 * 3 * 256; it += NGT) { const int c = it & 255, j = (it >> 8) % 3, b = it / (3 * 256); a.out[O_CONVS + (size_t)l * 32 * 3 * 256 + it] = bf2f(Z[(size_t)(MP + b * 16 + 13 + j) * INW + ZC_XB + c]); }
}

template <bool FULL> DI void m3_elem_unit(const Args& a, LAS unsigned char* lds, int l, int ci) {
    int tid_ = threadIdx.x; asm volatile("" : "+v"(tid_));
    const int tid = tid_, lane = tid & 63, wave = tid >> 6; const Chunk ch = get_chunk(ci);
    const bf16* Z = (const bf16*)(a.ws + WS_HZ); bf16* MIX = (bf16*)(a.ws + WS_MIX);
    LAS bf16* ZP = (LAS bf16*)(lds + L_ZP);
    const bool hist_z = (!ch.smp && ch.cis > 0);
    {
        u32x4 v[5];
#pragma unroll
        for (int it = 0; it < 5; ++it) { const int idx = tid + it * NT, rr = idx >> 5, pc = idx & 31, tp = rr - 15;
            const bool use_z = (idx < ((FULL ? 64 : ch.nv) + 15) * 32) && (tp >= 0 || hist_z);
            v[it] = *(const u32x4*)(Z + (size_t)(ch.row0 + (use_z ? tp : 0)) * INW + ZC_POOL + pc * 8);
            if (!use_z) v[it] = (u32x4){0u, 0u, 0u, 0u}; }
#pragma unroll
        for (int it = 0; it < 5; ++it) { const int idx = tid + it * NT, rr = idx >> 5, pc = idx & 31, tp = rr - 15;
            if (idx < ((FULL ? 64 : ch.nv) + 15) * 32) {
                u32x4 x = v[it];
                if (!FULL && ch.smp && tp < 0) { const f32x4* p = (const f32x4*)(a.in[2] + ((size_t)(l * 32 + ch.b) * 15 + (15 + tp)) * 256 + pc * 8); const f32x4 p0 = p[0], p1 = p[1];
                    x.x = pk2(p0[0], p0[1]); x.y = pk2(p0[2], p0[3]); x.z = pk2(p1[0], p1[1]); x.w = pk2(p1[2], p1[3]); }
                *(LAS u32x4*)(ZP + rr * 256 + pc * 8) = x; } }
    }
    const int grp = wave & 3, c4 = grp * 64 + (lane & 15) * 4, tq = (lane >> 4) + 4 * (wave >> 2);
    {
        const float* HL = (const float*)(a.ws + WS_HL); const float* PP = (const float*)(a.ws + WS_PP);
        const f32x4 car = *(const f32x4*)((const float*)(a.ws + WS_CARRY) + (size_t)ci * 256 + c4);
#pragma unroll
        for (int i = 0; i < 8; ++i) { const int t = tq + 8 * i;
            if (FULL || t < ch.nv) { const size_t r = ch.row0 + t; const f32x4 hl = *(const f32x4*)(HL + r * 256 + c4), pp = *(const f32x4*)(PP + r * 256 + c4); const u32x2 gz = *(const u32x2*)(Z + r * INW + ZC_GB + c4);
                const f32x4 hv = hl + pp * car;
                u32x2 o; o.x = pk2(hv[0] * gelu_tanh(__uint_as_float(gz.x << 16)), hv[1] * gelu_tanh(__uint_as_float(gz.x & 0xffff0000u)));
                o.y = pk2(hv[2] * gelu_tanh(__uint_as_float(gz.y << 16)), hv[3] * gelu_tanh(__uint_as_float(gz.y & 0xffff0000u)));
                *(u32x2*)(MIX + r * D + 256 + c4) = o; } }
    }
    BAR_LDS();
    {
        const int win = 2 << grp; const int pos0 = ch.smp ? 2048 : ch.cis * 64;
#pragma unroll
        for (int i = 0; i < 8; ++i) { const int t = tq + 8 * i;
            if (FULL || t < ch.nv) {
                f32x4 sm = (f32x4){0.f, 0.f, 0.f, 0.f};
                for (int j = 0; j < win; ++j) { const u32x2 x = *(const LAS u32x2*)(ZP + (t + 15 - j) * 256 + c4);
                    sm[0] += __uint_as_float(x.x << 16); sm[1] += __uint_as_float(x.x & 0xffff0000u); sm[2] += __uint_as_float(x.y << 16); sm[3] += __uint_as_float(x.y & 0xffff0000u); }
                const u32x2 x = *(const LAS u32x2*)(ZP + (t + 15) * 256 + c4);
                const int pos = pos0 + t; const float ic = frcp((float)((pos + 1 < win) ? pos + 1 : win));
                u32x2 o; o.x = pk2(sm[0] * ic - __uint_as_float(x.x << 16), sm[1] * ic - __uint_as_float(x.x & 0xffff0000u)); o.y = pk2(sm[2] * ic - __uint_as_float(x.y << 16), sm[3] * ic - __uint_as_float(x.y & 0xffff0000u));
                *(u32x2*)(MIX + (size_t)(ch.row0 + t) * D + c4) = o;
            } }
    }
    BAR_LDS();
}

template <bool FULL> DI void m3_hgrn_unit(const HgPre& p, const Args& a, LAS unsigned char* lds, int l, int ci, int h, int tid) {
    const int lane = tid & 63, wave = tid >> 6;
    const Chunk ch = get_chunk(ci);
    const bf16* Z = (const bf16*)(a.ws + WS_HZ); const float* LB = (const float*)(a.ws + WS_LB);
    LAS bf16* QT = (LAS bf16*)(lds + L_QT); LAS bf16* KT = (LAS bf16*)(lds + L_KT); LAS bf16* QH = (LAS bf16*)(lds + L_QH); LAS bf16* VT = (LAS bf16*)(lds + L_VT);
    LAS bf16* ATT = (LAS bf16*)(lds + L_ATT); LAS float* SEG = (LAS float*)(lds + L_SEG); LAS float* RED = (LAS float*)(lds + L_RED);
    const int quad = lane >> 4, l15 = lane & 15, v0 = wave * 16 + quad * 4;
    HG_LOAD_F();
    const f32x4 ng = *(const f32x4*)(a.in[22] + l * 512 + h * 128 + v0);
    bf16x8 sf[4]; u32x2 gzr[4];
    { const bf16* ST = (const bf16*)(a.ws + WS_US) + (size_t)(ci * 4 + h) * 16384 + (wave * 16 + l15) * 128 + quad * 8;
#pragma unroll
      for (int ks = 0; ks < 4; ++ks) sf[ks] = *(const bf16x8*)(ST + ks * 32);
#pragma unroll
      for (int tt = 0; tt < 4; ++tt) { const int t = tt * 16 + l15; gzr[tt] = (FULL || t < ch.nv) ? *(const u32x2*)(Z + (size_t)(ch.row0 + t) * INW + ZC_G + h * 128 + v0) : (u32x2){0u, 0u}; } }
    HG_CUMSUM();
    (void)blast0; (void)blast1;
    {
        const float eb0 = fexp(bref0), eb1 = fexp(bref1);
#pragma unroll
        for (int i = 0; i < 8; ++i) { const int t = sg * 8 + i; const bool ok = FULL || t < ch.nv;
            const float q0 = ok ? siluf(__uint_as_float(p.q[i] << 16)) : 0.f, q1 = ok ? siluf(__uint_as_float(p.q[i] & 0xffff0000u)) : 0.f;
            const float d0 = clampf(bc0[i] - bref0, -80.f, 80.f), d1 = clampf(bc1[i] - bref1, -80.f, 80.f);
            const float e0 = fexp(d0), e1 = fexp(d1), qe0 = q0 * e0, qe1 = q1 * e1;
            *(LAS unsigned*)(QT + t * 136 + 2 * kp) = pk2(qe0, qe1);
            *(LAS unsigned*)(KT + t * 136 + 2 * kp) = pk2(kk0[i] * frcp(e0), kk1[i] * frcp(e1));
            *(LAS unsigned*)(QH + t * 136 + 2 * kp) = pk2(qe0 * eb0, qe1 * eb1); }
    }
    HG_STORE_VT();
    BAR_LDS();
#pragma unroll
    for (int x = 0; x < 2; ++x) {
        const int idx = wave * 2 + x, tt = idx >> 2, st = idx & 3;
        f32x4 acc = (f32x4){0.f, 0.f, 0.f, 0.f};
        if (st <= tt) {
#pragma unroll
            for (int ks = 0; ks < 4; ++ks) { const bf16x8 af = *(const LAS bf16x8*)(KT + (st * 16 + l15) * 136 + ks * 32 + quad * 8); const bf16x8 bfr = *(const LAS bf16x8*)(QT + (tt * 16 + l15) * 136 + ks * 32 + quad * 8); acc = mfma16(af, bfr, acc); }
        }
        const int t = tt * 16 + l15, s0 = st * 16 + quad * 4;
        u32x2 o; o.x = pk2(s0 <= t ? acc[0] : 0.f, s0 + 1 <= t ? acc[1] : 0.f); o.y = pk2(s0 + 2 <= t ? acc[2] : 0.f, s0 + 3 <= t ? acc[3] : 0.f);
        *(LAS u32x2*)(ATT + t * 72 + s0) = o;
    }
    f32x4 oacc[4];
#pragma unroll
    for (int tt = 0; tt < 4; ++tt) oacc[tt] = (f32x4){0.f, 0.f, 0.f, 0.f};
    {
#pragma unroll
        for (int tt = 0; tt < 4; ++tt)
#pragma unroll
            for (int ks = 0; ks < 4; ++ks) { const bf16x8 bfr = *(const LAS bf16x8*)(QH + (tt * 16 + l15) * 136 + ks * 32 + quad * 8); oacc[tt] = mfma16(sf[ks], bfr, oacc[tt]); }
    }
    BAR_LDS();
    {
        bf16x8 vf[2];
#pragma unroll
        for (int ks = 0; ks < 2; ++ks) vf[ks] = *(const LAS bf16x8*)(VT + (wave * 16 + l15) * 72 + ks * 32 + quad * 8);
#pragma unroll
        for (int tt = 0; tt < 4; ++tt)
#pragma unroll
            for (int ks = 0; ks < 2; ++ks) { const bf16x8 bfr = *(const LAS bf16x8*)(ATT + (tt * 16 + l15) * 72 + ks * 32 + quad * 8); oacc[tt] = mfma16(vf[ks], bfr, oacc[tt]); }
    }
#pragma unroll
    for (int tt = 0; tt < 4; ++tt) { float s = (oacc[tt][0] * oacc[tt][0] + oacc[tt][1] * oacc[tt][1]) + (oacc[tt][2] * oacc[tt][2] + oacc[tt][3] * oacc[tt][3]);
        s += __shfl_xor(s, 16); s += __shfl_xor(s, 32); if (quad == 0) RED[wave * 64 + tt * 16 + l15] = s; }
    BAR_LDS();
    bf16* MIX = (bf16*)(a.ws + WS_MIX);
#pragma unroll
    for (int tt = 0; tt < 4; ++tt) { const int t = tt * 16 + l15;
        if (FULL || t < ch.nv) {
            float s = 0.f;
#pragma unroll
            for (int w = 0; w < 8; ++w) s += RED[w * 64 + t];
            const float rs = rsqrtf(s * (1.f / 128.f) + EPS);
            const size_t r = ch.row0 + t; const u32x2 gz = gzr[tt];
            const float g0 = siluf(__uint_as_float(gz.x << 16)), g1 = siluf(__uint_as_float(gz.x & 0xffff0000u)), g2 = siluf(__uint_as_float(gz.y << 16)), g3 = siluf(__uint_as_float(gz.y & 0xffff0000u));
            u32x2 o; o.x = pk2(oacc[tt][0] * rs * ng[0] * g0, oacc[tt][1] * rs * ng[1] * g1); o.y = pk2(oacc[tt][2] * rs * ng[2] * g2, oacc[tt][3] * rs * ng[3] * g3);
            *(u32x2*)(MIX + r * D + 512 + h * 128 + v0) = o;
        } }
    BAR_LDS();
}

DI void pf_final(const Args& a) {
    int tid_ = threadIdx.x; asm volatile("" : "+v"(tid_));
    const int lane = tid_ & 63, gw = opaque_bid() * 8 + (tid_ >> 6), NGW = opaque_i(gridDim.x * 8);
    const f32x4* fn = (const f32x4*)a.in[28]; const bf16* XB = (const bf16*)(a.ws + WS_XB); const float* SSQ = (const float*)(a.ws + WS_SSQ);
    f32x4 g[4];
#pragma unroll
    for (int j = 0; j < 4; ++j) g[j] = fn[64 * j + lane];
    for (int m0 = gw; m0 < M; m0 += 4 * NGW) {
        u32x2 x[4][4]; f32x4 p[4];
#pragma unroll
        for (int q = 0; q < 4; ++q) { const int m = (m0 + q * NGW < M) ? m0 + q * NGW : m0;
            p[q] = *(const f32x4*)(SSQ + (size_t)m * 16 + (lane & 3) * 4);
#pragma unroll
            for (int j = 0; j < 4; ++j) x[q][j] = ((const u32x2*)(XB + (size_t)m * D))[64 * j + lane]; }
#pragma unroll
        for (int q = 0; q < 4; ++q) { const int m = m0 + q * NGW;
            if (m < M) {
                float sq = (p[q][0] + p[q][1]) + (p[q][2] + p[q][3]); sq += __shfl_xor(sq, 1); sq += __shfl_xor(sq, 2);
                const float r = rsqrtf(sq * (1.f / 1024.f) + EPS);
                f32x4* yr = (f32x4*)(a.out + (size_t)m * D);
#pragma unroll
                for (int j = 0; j < 4; ++j) { f32x4 v;
                    v[0] = __uint_as_float(x[q][j].x << 16) * r * g[j][0]; v[1] = __uint_as_float(x[q][j].x & 0xffff0000u) * r * g[j][1]; v[2] = __uint_as_float(x[q][j].y << 16) * r * g[j][2]; v[3] = __uint_as_float(x[q][j].y & 0xffff0000u) * r * g[j][3];
                    __builtin_nontemporal_store(v, yr + 64 * j + lane); } } }
    }
}

#define RLX_AGENT __ATOMIC_RELAXED, __HIP_MEMORY_SCOPE_AGENT
#define XB_TMO      128
#define XB_XCNT(j)  (256  + 64 * (j))
#define XB_XSUB(j)  (1280 + 64 * (j))
#define XB_XGEN(j)  (2304 + 64 * (j))
#define XB_TOP      3328
#define XB_TOPGEN   3392
#define XCD_BAR_WORDS 3456
#define XB_SPIN_CAP (1u << 18)

__device__ __forceinline__ unsigned xb_ld(unsigned* p)              { return __hip_atomic_load(p, __ATOMIC_RELAXED, __HIP_MEMORY_SCOPE_AGENT); }
__device__ __forceinline__ unsigned xb_add(unsigned* p, unsigned v) { return __hip_atomic_fetch_add(p, v, __ATOMIC_RELAXED, __HIP_MEMORY_SCOPE_AGENT); }
__device__ __forceinline__ unsigned xb_xcc_id() { return (unsigned)__builtin_amdgcn_s_getreg((3 << 11) | 20) & 0xFu; }
#define XB_SPIN(cond, bar) do { unsigned _sp = 0; while (cond) { __builtin_amdgcn_s_sleep(1); \
    if ((++_sp & 255u) == 0u) { if (xb_ld(&(bar)[XB_TMO])) break; if (_sp > XB_SPIN_CAP) { atomicAdd(&(bar)[XB_TMO], 1u); break; } } } } while (0)

struct XcdBarrier {
    unsigned* bar; unsigned x;
    volatile LAS unsigned* st;
};

__device__ __forceinline__ XcdBarrier xcd_barrier_post(unsigned* bar, volatile LAS unsigned* st) {
    XcdBarrier b; b.bar = bar; b.x = xb_xcc_id(); b.st = st;
    if (threadIdx.x == 0) (void)xb_add(&bar[XB_XCNT(b.x)], 1u);
    return b;
}
__device__ __forceinline__ void xcd_barrier_complete(unsigned* bar, unsigned x, unsigned& nloc, unsigned& nx) {
    const unsigned G = gridDim.x * gridDim.y * gridDim.z;
    unsigned sum, cnt, mine, sp = 0u;
    for (;;) {
        sum = 0u; cnt = 0u; mine = 0u;
#pragma unroll
        for (unsigned j = 0; j < 16; ++j) { const unsigned c = xb_ld(&bar[XB_XCNT(j)]); sum += c; cnt += (c > 0u) ? 1u : 0u; mine = (j == x) ? c : mine; }
        if (sum == G) break;
        __builtin_amdgcn_s_sleep(1);
        if ((++sp & 255u) == 0u) { if (xb_ld(&bar[XB_TMO])) break; if (sp > XB_SPIN_CAP) { atomicAdd(&bar[XB_TMO], 1u); break; } }
    }
    nloc = mine > 0u ? mine : 1u; nx = cnt > 0u ? cnt : 1u;
}

__device__ __forceinline__ void xcd_barrier(const XcdBarrier& b) {
    asm volatile("s_waitcnt vmcnt(0)" ::: "memory");
    __syncthreads();
    if (threadIdx.x == 0) {
        unsigned* bar = b.bar;
        __builtin_amdgcn_s_waitcnt(0);
        unsigned nloc = b.st[0], nx = b.st[1];
        if (nloc == 0u) { xcd_barrier_complete(bar, b.x, nloc, nx); b.st[0] = nloc; b.st[1] = nx; }
        const unsigned old = xb_add(&bar[XB_XSUB(b.x)], 1u);
        const unsigned gen = old / nloc;
        if (old + 1u == (gen + 1u) * nloc) {
            __builtin_amdgcn_fence(__ATOMIC_RELEASE, "agent");
            asm volatile("s_waitcnt vmcnt(0)" ::: "memory");
            const unsigned og = xb_add(&bar[XB_TOP], 1u);
            const unsigned tg = og / nx;
            if (og + 1u == (tg + 1u) * nx) xb_add(&bar[XB_TOPGEN], 1u);
            else XB_SPIN(xb_ld(&bar[XB_TOPGEN]) == tg, bar);
            __builtin_amdgcn_fence(__ATOMIC_ACQUIRE, "agent");
            xb_add(&bar[XB_XGEN(b.x)], 1u);
            asm volatile("s_waitcnt vmcnt(0)" ::: "memory");
        } else {
            XB_SPIN(xb_ld(&bar[XB_XGEN(b.x)]) == gen, bar);
            __builtin_amdgcn_fence(__ATOMIC_ACQUIRE, "agent");
            asm volatile("s_waitcnt vmcnt(0)" ::: "memory");
        }
    }
    __syncthreads();
}

__global__ void __launch_bounds__(NT, 2) fwd_kernel(Args a) {
    extern __shared__ __attribute__((aligned(16))) unsigned char lds_raw[];
    LAS unsigned char* lds = (LAS unsigned char*)lds_raw;
    cg::grid_group grid = cg::this_grid();
    unsigned char* ws = a.ws;
    const int G = gridDim.x, bid = blockIdx.x;
    int ph = 0;
    volatile LAS unsigned* bst = (volatile LAS unsigned*)(lds + LDS_BYTES - 64);
    unsigned* barw = (unsigned*)(ws + WS_BAR);
    XcdBarrier xbar; xbar.bar = barw; xbar.x = 0; xbar.st = bst;
#ifndef PHMASK
#define PHMASK 0xFFFFFFFFu
#endif
#ifndef REPMASK
#define REPMASK 0u
#endif
#define PH_BEGIN(id) if (((PHMASK >> (id)) & 1u) && ph >= a.ph_lo && ph < a.ph_hi) { constexpr int NREP = ((REPMASK >> (id)) & 1u) ? 2 : 1; for (int rep = 0; rep < NREP; ++rep) { const bool dummy = (rep + 1 < NREP); if (rep > 0) xcd_barrier(xbar);
#define PH_END   } if (ph + 1 < a.ph_hi) xcd_barrier(xbar); } ++ph;
    {
        if (ph >= a.ph_lo && ph < a.ph_hi) {
            if (bid == 0) for (int i = threadIdx.x; i < XCD_BAR_WORDS; i += NT) __hip_atomic_store(barw + i, 0u, RLX_AGENT);
            if (threadIdx.x < 2) bst[threadIdx.x] = 0u;
            for (int rep = 0; rep < (((REPMASK >> 0) & 1u) ? 2 : 1); ++rep) p0_prologue(a, lds);
            grid.sync();
            xbar = xcd_barrier_post(barw, bst);
        }
        ++ph;
    }
    bf16* XB = (bf16*)(ws + WS_XB); bf16* HZ = (bf16*)(ws + WS_HZ); bf16* MIX = (bf16*)(ws + WS_MIX); float* SSQ = (float*)(ws + WS_SSQ);
    for (int st = 0; st < 4; ++st) {
        const int l = st >> 1;
        PH_BEGIN(1) {
            pg8::Gemm g{XB, (const bf16*)(ws + WS_WGU + st * SZ_WGU), M, 2 * DFF, D}; pg8::StaticOrder S; S.init(M, 2 * DFF, G, bid);
            EpiSwiglu E{HZ, SSQ, lds};
            pg8::gemm_phase<EpiSwiglu, pg8::StaticOrder, true, true>(lds, g, S, E);
        } PH_END
        PH_BEGIN(2) {
            pg8::Gemm g{HZ, (const bf16*)(ws + WS_WD + st * SZ_WD), M, D, DFF}; DownOrder S; S.init(G, bid);
            EpiResid E{XB, dummy ? MIX : XB, dummy ? (float*)(ws + 963 * MiB) : SSQ, 0.5f, (float*)(ws + WS_US)};
            pg8::gemm_phase<EpiResid, DownOrder, true, true>(lds, g, S, E);
        } PH_END
        PH_BEGIN(9) { down_reduce(a); } PH_END
        if ((st & 1) == 0) {
            PH_BEGIN(3) {
                pg8::Gemm g{XB, (const bf16*)(ws + WS_WIN + l * SZ_WIN), M, INW, D}; pg8::StaticOrder S; S.init(M, INW, G, bid);
                EpiScale E{HZ, SSQ, INW, lds};
                pg8::gemm_phase<EpiScale, pg8::StaticOrder, true, true>(lds, g, S, E);
            } PH_END
            PH_BEGIN(4) {
                for (int r2 = 0; r2 < (((REPMASK >> 9) & 1u) ? 2 : 1); ++r2) for (int u = bid; u < NCH; u += G) { if (u < NCH_P) m1_lru_unit<true>(a, lds, l, u); else m1_lru_unit<false>(a, lds, l, u); }
                for (int r2 = 0; r2 < (((REPMASK >> 10) & 1u) ? 2 : 1); ++r2) { int tid_ = threadIdx.x; asm volatile("" : "+v"(tid_)); const int tid = tid_;
                    int u = bid; while (u < NCH) u += G;     HgPre nx{}; if (u < NCH * 5) hg_load<false>(nx, a, (u - NCH) >> 2, (u - NCH) & 3, tid);
                    for (; u < NCH * 5; u += G) { const HgPre cur = nx; const int un = u + G; if (un < NCH * 5) hg_load<false>(nx, a, (un - NCH) >> 2, (un - NCH) & 3, tid);
                        if (((u - NCH) >> 2) < NCH_P) m1_hgrn_unit<true>(cur, a, lds, l, (u - NCH) >> 2, (u - NCH) & 3, tid); else m1_hgrn_unit<false>(cur, a, lds, l, (u - NCH) >> 2, (u - NCH) & 3, tid); } }
            } PH_END
            PH_BEGIN(5) { m2_scan(a, l); } PH_END
            PH_BEGIN(6) {
                for (int r2 = 0; r2 < (((REPMASK >> 11) & 1u) ? 2 : 1); ++r2) for (int u = bid; u < NCH; u += G) { if (u < NCH_P) m3_elem_unit<true>(a, lds, l, u); else m3_elem_unit<false>(a, lds, l, u); }
                for (int r2 = 0; r2 < (((REPMASK >> 12) & 1u) ? 2 : 1); ++r2) { int tid_ = threadIdx.x; asm volatile("" : "+v"(tid_)); const int tid = tid_;
                    int u = bid; while (u < NCH) u += G;     HgPre nx{}; if (u < NCH * 5) hg_load<true>(nx, a, (u - NCH) >> 2, (u - NCH) & 3, tid);
                    for (; u < NCH * 5; u += G) { const HgPre cur = nx; const int un = u + G; if (un < NCH * 5) hg_load<true>(nx, a, (un - NCH) >> 2, (un - NCH) & 3, tid);
                        if (((u - NCH) >> 2) < NCH_P) m3_hgrn_unit<true>(cur, a, lds, l, (u - NCH) >> 2, (u - NCH) & 3, tid); else m3_hgrn_unit<false>(cur, a, lds, l, (u - NCH) >> 2, (u - NCH) & 3, tid); } }
            } PH_END
            PH_BEGIN(7) {
                pg8::Gemm g{MIX, (const bf16*)(ws + WS_WOUT + l * SZ_WOUT), M, D, D}; pg8::StaticOrder S; S.init(M, D, G, bid);
                EpiResid E{XB, dummy ? HZ : XB, dummy ? (float*)(ws + 963 * MiB) : SSQ, 1.0f, nullptr};
                pg8::gemm_phase<EpiResid, pg8::StaticOrder, true, true>(lds, g, S, E);
            } PH_END
        }
    }
    PH_BEGIN(8) pf_final(a); PH_END
}

#ifndef MK_PER_PHASE
#define MK_PER_PHASE 0
#endif
constexpr int N_PHASES = 1 + 4 * 3 + 2 * 5 + 1;
extern "C" void kernel_launch(void* const* d_in, const int* in_sizes, int n_in, void* d_out, int out_size, void* d_ws, size_t ws_size, hipStream_t stream) {
    static int grid = 0;
    if (grid == 0) {
        if (n_in != 29 || (size_t)out_size != O_END || ws_size < WS_END + (REPMASK ? 8 * MiB : 0)) { fprintf(stderr, "kernel_launch: unexpected shapes: n_in %d out %d ws %zu (need %zu)\n", n_in, out_size, ws_size, (size_t)WS_END); grid = -1; return; }
        int dev = 0, cus = 0, per_cu = 0;
        if (hipGetDevice(&dev) != hipSuccess || hipDeviceGetAttribute(&cus, hipDeviceAttributeMultiprocessorCount, dev) != hipSuccess) { grid = -1; return; }
        if (hipFuncSetAttribute((const void*)fwd_kernel, hipFuncAttributeMaxDynamicSharedMemorySize, LDS_BYTES) != hipSuccess) { fprintf(stderr, "kernel_launch: hipFuncSetAttribute failed\n"); grid = -1; return; }
        if (hipOccupancyMaxActiveBlocksPerMultiprocessor(&per_cu, (const void*)fwd_kernel, NT, LDS_BYTES) != hipSuccess || per_cu < 1) { fprintf(stderr, "kernel_launch: occupancy query says %d\n", per_cu); per_cu = 1; }
        (void)hipGetLastError();
        grid = cus * per_cu;
    }
    if (grid < 0) return;
    Args a{};
    for (int i = 0; i < 29; ++i) a.in[i] = (const float*)d_in[i];
    a.out = (float*)d_out; a.ws = (unsigned char*)d_ws;
#if MK_PER_PHASE
    for (int p = 0; p < N_PHASES; ++p) { a.ph_lo = p; a.ph_hi = p + 1; void* args[] = {&a};
        hipError_t e = hipLaunchCooperativeKernel((const void*)fwd_kernel, dim3(grid), dim3(NT), args, LDS_BYTES, stream);
        if (e != hipSuccess) { fprintf(stderr, "launch %d failed: %s\n", p, hipGetErrorString(e)); break; } }
#else
    a.ph_lo = 0; a.ph_hi = N_PHASES; void* args[] = {&a};
    hipError_t e = hipLaunchCooperativeKernel((const void*)fwd_kernel, dim3(grid), dim3(NT), args, LDS_BYTES, stream);
    if (e != hipSuccess) fprintf(stderr, "cooperative launch failed: %s (grid %d)\n", hipGetErrorString(e), grid);
#endif
}
```
